# Optimizing an MI355X kernel written in HIP

```python
import functools
import jax, jax.numpy as jnp
from jax import lax
import numpy as np

D_MODEL = 1024
BATCH = 32
SEQ = 256
DEPTH = 1
DEC_BATCH = 8
DEC_SEQ = 4096
PAST_LEN = 512

GRID_W = 64
D_MIX = D_MODEL
D_REC = D_MIX // 2
D_POOL = D_MIX - D_REC
REC_HEADS = 4
REC_DK = D_REC // REC_HEADS
REC_DV = D_REC // REC_HEADS
CHUNK = 32
POOL_WINDOWS = (2, 4, 8, 16)
POOL_GROUPS = len(POOL_WINDOWS)
POOL_GW = D_POOL // POOL_GROUPS
D_IN = 5 * D_REC + D_POOL
D_FF = -(-8 * D_MODEL // (3 * 256)) * 256
DEEPNORM_ALPHA = (2.0 * DEPTH) ** 0.25
DEEPNORM_BETA = (8.0 * DEPTH) ** -0.25
LN_EPS = 1e-5
RMS_EPS = 1e-6

kernel_name = "hymba_hgrn2_pool_dit_step"


def layer_norm(x, g, b):
    xf = x.astype(jnp.float32)
    mu = jnp.mean(xf, axis=-1, keepdims=True)
    var = jnp.mean(jnp.square(xf - mu), axis=-1, keepdims=True)
    return ((xf - mu) * lax.rsqrt(var + LN_EPS) * g + b).astype(x.dtype)


def lower_bounds(raw):
    return jnp.cumsum(jax.nn.softmax(raw.astype(jnp.float32), axis=0), axis=0)


def hgrn2_chunked(q, k, log_f, v, s0):
    bsz, t, h, _ = q.shape
    dv = v.shape[-1]
    n = t // CHUNK

    def blocks(a):
        return a.astype(jnp.float32).reshape(bsz, n, CHUNK, h, a.shape[-1]).transpose(0, 3, 1, 2, 4)

    qc, kc, gc, vc = blocks(q), blocks(k), blocks(log_f), blocks(v)
    b = jnp.cumsum(gc, axis=3)
    b_last = b[:, :, :, -1:]
    q_dec = qc * jnp.exp(b)
    k_inv = kc * jnp.exp(-b)
    k_end = kc * jnp.exp(b_last - b)
    mask = jnp.tril(jnp.ones((CHUNK, CHUNK), dtype=bool))
    scores = jnp.where(mask, jnp.einsum('bhncd,bhnsd->bhncs', q_dec, k_inv), 0.0)
    o_intra = jnp.einsum('bhncs,bhnse->bhnce', scores, vc)
    u = jnp.einsum('bhnsd,bhnse->bhnde', k_end, vc)
    decay = jnp.exp(b_last[:, :, :, 0])

    def step(s, xs):
        dec_n, u_n = xs
        return dec_n[..., None] * s + u_n, s

    s_final, s_starts = lax.scan(step, s0.astype(jnp.float32),
                                 (jnp.moveaxis(decay, 2, 0), jnp.moveaxis(u, 2, 0)))
    s_starts = jnp.moveaxis(s_starts, 0, 2)
    o_inter = jnp.einsum('bhncd,bhnde->bhnce', q_dec, s_starts)
    o = (o_intra + o_inter).transpose(0, 2, 3, 1, 4).reshape(bsz, t, h, dv)
    return o, s_final


def _window_bounds(n, w):
    idx = jnp.arange(n)
    return jnp.clip(idx - w // 2, 0, n), jnp.clip(idx + w // 2, 0, n)


def pool_1d(u, w):
    t = u.shape[1]
    cs = jnp.pad(jnp.cumsum(u.astype(jnp.float32), axis=1), ((0, 0), (1, 0), (0, 0)))
    lo, hi = _window_bounds(t, w)
    total = jnp.take(cs, hi, axis=1) - jnp.take(cs, lo, axis=1)
    return total / (hi - lo).astype(jnp.float32)[None, :, None]


def pool_2d(u, w, rows):
    bsz, t, ch = u.shape
    g = u.astype(jnp.float32).reshape(bsz, rows, GRID_W, ch)
    sat = jnp.pad(jnp.cumsum(jnp.cumsum(g, axis=1), axis=2), ((0, 0), (1, 0), (1, 0), (0, 0)))
    r0, r1 = _window_bounds(rows, w)
    c0, c1 = _window_bounds(GRID_W, w)

    def corner(ri, ci):
        return jnp.take(jnp.take(sat, ri, axis=1), ci, axis=2)

    total = corner(r1, c1) - corner(r0, c1) - corner(r1, c0) + corner(r0, c0)
    cnt = ((r1 - r0)[:, None] * (c1 - c0)[None, :]).astype(jnp.float32)
    return (total / cnt[None, :, :, None]).reshape(bsz, t, ch)


def multi_scale_pool(u, pool_w, pool_scale, pool_fn):
    outs = []
    for gi, w in enumerate(POOL_WINDOWS):
        ug = u[..., gi * POOL_GW:(gi + 1) * POOL_GW]
        diff = (pool_fn(ug, w) - ug.astype(jnp.float32)).astype(u.dtype)
        outs.append(diff @ pool_w[gi])
    return jnp.concatenate(outs, axis=-1) * pool_scale


def hybrid_mixer(h, s_fwd0, s_bwd0, pool_fn, w_in, lb_fwd, lb_bwd, hgrn_norm_g, pool_w, pool_scale, w_out):
    bsz, t, _ = h.shape
    proj = h @ w_in
    q, z_fwd, z_bwd, i_in, g, u_pool = jnp.split(
        proj, [D_REC, 2 * D_REC, 3 * D_REC, 4 * D_REC, 5 * D_REC], axis=-1)
    heads_k = (bsz, t, REC_HEADS, REC_DK)
    q = jax.nn.silu(q).reshape(heads_k)
    v = i_in.reshape(bsz, t, REC_HEADS, REC_DV)

    def gates(z, lb):
        f = lb.reshape(REC_HEADS, REC_DK) + (1.0 - lb.reshape(REC_HEADS, REC_DK)) * jax.nn.sigmoid(
            z.astype(jnp.float32).reshape(heads_k))
        return 1.0 - f, jnp.log(f)

    k_f, log_f_f = gates(z_fwd, lb_fwd)
    k_b, log_f_b = gates(z_bwd, lb_bwd)
    o_f, s_f = hgrn2_chunked(q, k_f, log_f_f, v, s_fwd0)
    o_b_rev, s_b = hgrn2_chunked(q[:, ::-1], k_b[:, ::-1], log_f_b[:, ::-1], v[:, ::-1], s_bwd0)
    o = o_f + o_b_rev[:, ::-1]
    o = o * lax.rsqrt(jnp.mean(jnp.square(o), axis=-1, keepdims=True) + RMS_EPS) * hgrn_norm_g
    y_rec = o.reshape(bsz, t, D_REC).astype(h.dtype) * jax.nn.silu(g)
    y_pool = multi_scale_pool(u_pool, pool_w, pool_scale, pool_fn)
    y = jnp.concatenate([y_rec, y_pool.astype(h.dtype)], axis=-1) @ w_out
    return y, s_f, s_b


def trunk_layer(x, mod, s_fwd0, s_bwd0, pool_fn, w_in, lb_fwd, lb_bwd, hgrn_norm_g, pool_w, pool_scale,
                w_out, ln1_g, ln1_b, w_ffn_gate, w_ffn_up, w_ffn_down, ln2_g, ln2_b):
    shift1, scale1, gate1, shift2, scale2, gate2 = jnp.split(mod, 6, axis=-1)
    h = x * (1.0 + scale1) + shift1
    y, s_f, s_b = hybrid_mixer(h, s_fwd0, s_bwd0, pool_fn, w_in, lb_fwd, lb_bwd, hgrn_norm_g,
                               pool_w, pool_scale, w_out)
    x = layer_norm(DEEPNORM_ALPHA * x + gate1 * y, ln1_g, ln1_b)
    h = x * (1.0 + scale2) + shift2
    ffn = (jax.nn.silu(h @ w_ffn_gate) * (h @ w_ffn_up)) @ w_ffn_down
    x = layer_norm(DEEPNORM_ALPHA * x + gate2 * ffn, ln2_g, ln2_b)
    return x, s_f, s_b


def setup_inputs(seed: int = 0) -> dict:
    key = jax.random.key(seed)
    ks = jax.random.split(key, 22)
    nrm = jax.random.normal
    f32 = jnp.float32
    state_shape = (DEC_BATCH, DEPTH, REC_HEADS, REC_DK, REC_DV)
    return {
        'x_prompt': nrm(ks[0], (BATCH, SEQ, D_MODEL), f32),
        'x_sample': nrm(ks[1], (DEC_BATCH, DEC_SEQ, D_MODEL), f32),
        'state_hgrn_fwd': 0.5 * nrm(ks[2], state_shape, f32),
        'state_hgrn_bwd': 0.5 * nrm(ks[3], state_shape, f32),
        'c': nrm(ks[4], (DEC_BATCH, D_MODEL), f32),
        'c_ctx': nrm(ks[5], (D_MODEL,), f32),
        'w_mod': 0.5 * D_MODEL ** -0.5 * nrm(ks[6], (DEPTH, D_MODEL, 6 * D_MODEL), f32),
        'b_mod': 0.01 * nrm(ks[7], (DEPTH, 6 * D_MODEL), f32),
        'w_in': D_MODEL ** -0.5 * nrm(ks[8], (DEPTH, D_MODEL, D_IN), f32),
        'lb_fwd_raw': 0.1 * nrm(ks[9], (DEPTH + 1, D_REC), f32),
        'lb_bwd_raw': 0.1 * nrm(ks[10], (DEPTH + 1, D_REC), f32),
        'hgrn_norm_g': 1.0 + 0.01 * nrm(ks[11], (DEPTH, REC_DV), f32),
        'pool_w': POOL_GW ** -0.5 * nrm(ks[12], (DEPTH, POOL_GROUPS, POOL_GW, POOL_GW), f32),
        'pool_scale': 1.0 + 0.01 * nrm(ks[13], (DEPTH, D_POOL), f32),
        'w_out': DEEPNORM_BETA * D_MIX ** -0.5 * nrm(ks[14], (DEPTH, D_MIX, D_MODEL), f32),
        'ln1_g': 1.0 + 0.01 * nrm(ks[15], (DEPTH, D_MODEL), f32),
        'ln1_b': 0.01 * nrm(ks[16], (DEPTH, D_MODEL), f32),
        'w_ffn_gate': D_MODEL ** -0.5 * nrm(ks[17], (DEPTH, D_MODEL, D_FF), f32),
        'w_ffn_up': D_MODEL ** -0.5 * nrm(ks[18], (DEPTH, D_MODEL, D_FF), f32),
        'w_ffn_down': DEEPNORM_BETA * D_FF ** -0.5 * nrm(ks[19], (DEPTH, D_FF, D_MODEL), f32),
        'ln2_g': 1.0 + 0.01 * nrm(ks[20], (DEPTH, D_MODEL), f32),
        'ln2_b': 0.01 * nrm(ks[21], (DEPTH, D_MODEL), f32),
    }


def reference(x_prompt, x_sample, state_hgrn_fwd, state_hgrn_bwd, c, c_ctx, w_mod, b_mod, w_in,
              lb_fwd_raw, lb_bwd_raw, hgrn_norm_g, pool_w, pool_scale, w_out, ln1_g, ln1_b,
              w_ffn_gate, w_ffn_up, w_ffn_down, ln2_g, ln2_b):
    rows = x_sample.shape[1] // GRID_W
    pool_lat = functools.partial(pool_2d, rows=rows)
    pool_ctx = pool_1d
    lb_fwd_all = lower_bounds(lb_fwd_raw)
    lb_bwd_all = lower_bounds(lb_bwd_raw)
    zero_state = jnp.zeros((x_prompt.shape[0], REC_HEADS, REC_DK, REC_DV), jnp.float32)
    xp, xs = x_prompt, x_sample
    new_fwd, new_bwd = [], []
    for l in range(DEPTH):
        layer = functools.partial(
            trunk_layer, w_in=w_in[l], lb_fwd=lb_fwd_all[l], lb_bwd=lb_bwd_all[l],
            hgrn_norm_g=hgrn_norm_g[l], pool_w=pool_w[l], pool_scale=pool_scale[l], w_out=w_out[l],
            ln1_g=ln1_g[l], ln1_b=ln1_b[l], w_ffn_gate=w_ffn_gate[l], w_ffn_up=w_ffn_up[l],
            w_ffn_down=w_ffn_down[l], ln2_g=ln2_g[l], ln2_b=ln2_b[l])
        mod_ctx = (jax.nn.silu(c_ctx) @ w_mod[l] + b_mod[l])[None, None, :]
        mod_lat = (jax.nn.silu(c) @ w_mod[l] + b_mod[l])[:, None, :]
        xp, s_f, s_b = layer(xp, mod_ctx, zero_state, zero_state, pool_ctx)
        new_fwd.append(s_f)
        new_bwd.append(s_b)
        xs, _, _ = layer(xs, mod_lat, state_hgrn_fwd[:, l], state_hgrn_bwd[:, l], pool_lat)
    new_state_hgrn_fwd = jnp.stack(new_fwd, axis=1)
    new_state_hgrn_bwd = jnp.stack(new_bwd, axis=1)
    return (xp, xs, new_state_hgrn_fwd, new_state_hgrn_bwd)
```

```cpp
#include <hip/hip_runtime.h>
#include <cstdio>
#include <cstdint>
namespace pg8 {
#define PG8_LAS __attribute__((address_space(3)))
typedef unsigned short bf16_t;
typedef short bf16x8 __attribute__((ext_vector_type(8)));
typedef float f32x4 __attribute__((ext_vector_type(4)));
typedef unsigned u32x4 __attribute__((ext_vector_type(4)));
constexpr int BM = 256, BK = 64, HALF = 128, HTB = HALF * BK * 2  , STAGE_BYTES = 8 * HTB, NXCD = 8, WGM = 8;

__host__ __device__ __forceinline__ int lds_byte(int r, int c) { const int st = (r >> 4) * 2 + (c >> 5), rr = r & 15, cc = c & 31, ob = rr * 64 + cc * 2; return st * 1024 + (ob ^ (((ob >> 9) & 1) << 5)); }
__host__ __device__ __forceinline__ void stage_rc(int b, int& R, int& C) { const int st = b / 1024, sb = b % 1024, swz = sb ^ (((sb >> 9) & 1) << 5); R = (st >> 1) * 16 + swz / 64; C = (st & 1) * 32 + (swz % 64) / 2; }
__host__ __device__ __forceinline__ int perm32(int rho) { const int n = rho >> 4, i = rho & 15; return 8 * (i >> 2) + 4 * n + (i & 3); }

struct Unit { int pm, pn; };
struct Gemm { const bf16_t* A; const bf16_t* Bt; int M, N, K; };

struct StaticOrder {
    int nM, nN, nwg, G, c;
    __host__ __device__ void init(int M, int N, int G_, int c_) { nM = M / BM; nN = N / BM; nwg = nM * nN; G = G_; c = c_; }
    __host__ __device__ bool next(int i, Unit& u) const {
        const long L = (long)i * G + c; if (L >= nwg) return false;
        int wgid = (int)L; { const int q = nwg / NXCD, r = nwg % NXCD, xcd = wgid % NXCD, off = wgid / NXCD; wgid = (xcd < r ? xcd * (q + 1) : r * (q + 1) + (xcd - r) * q) + off; }
        const int nig = WGM * nN, gid = wgid / nig, fm = gid * WGM, gsz = (nM - fm) < WGM ? (nM - fm) : WGM;
        u.pm = fm + ((wgid % nig) % gsz); u.pn = (wgid % nig) / gsz; return true;
    }
    __device__ __forceinline__ void a_ready(const Unit&) const {}
    __device__ __forceinline__ void done(const Unit&) const {}
};

typedef __bf16 bf16x2v __attribute__((ext_vector_type(2)));
typedef float f32x2v __attribute__((ext_vector_type(2)));
typedef unsigned u32x2 __attribute__((ext_vector_type(2)));
__device__ __forceinline__ unsigned pk2(float lo, float hi) { f32x2v f = {lo, hi}; bf16x2v v = __builtin_convertvector(f, bf16x2v); return __builtin_bit_cast(unsigned, v); }
__device__ __forceinline__ float bflo(unsigned u) { return __builtin_bit_cast(float, u << 16); }
__device__ __forceinline__ float bfhi(unsigned u) { return __builtin_bit_cast(float, u & 0xffff0000u); }
__device__ __forceinline__ float sigm_neg(float z) { return __builtin_amdgcn_rcpf(1.0f + __expf(z)); }
__device__ __forceinline__ float silu_f(float x) { return x * __builtin_amdgcn_rcpf(1.0f + __expf(-x)); }
constexpr float DN_ALPHA = 1.189207115002721f;
constexpr int DMODEL = 1024, DIN = 3072, DFF = 2816, MODW = 6144, NPROMPT = 8192;

struct EpiInProj {
    static constexpr bool PERM = true, AFTER_DRAIN = false;
    bf16_t* O; const float* lbf; const float* lbb;
    __device__ __forceinline__ void operator()(const f32x4 (&acc)[2][2][4][2], const Unit& u, int wr, int wc, int fr, int fq) const {
        const int row0 = u.pm * BM + wr * 64 + fr, col0 = u.pn * BM + wc * 32 + 8 * fq, sec = u.pn >> 1;
        f32x4 oml[2][2];
#pragma unroll
        for (int bj = 0; bj < 2; ++bj)
#pragma unroll
            for (int n = 0; n < 2; ++n) oml[bj][n] = (f32x4){0.f, 0.f, 0.f, 0.f};
        if (sec == 1 || sec == 2) {
            const float* lb = (sec == 1) ? lbf : lbb; const int cs = (u.pn & 1) * 256 + wc * 32 + 8 * fq;
#pragma unroll
            for (int bj = 0; bj < 2; ++bj)
#pragma unroll
                for (int n = 0; n < 2; ++n) { const f32x4 r0 = *(const f32x4*)(lb + cs + bj * HALF + 4 * n), r1 = *(const f32x4*)(lb + 512 + cs + bj * HALF + 4 * n);
#pragma unroll
                    for (int j = 0; j < 4; ++j) oml[bj][n][j] = __builtin_amdgcn_rcpf(1.0f + __expf(r0[j] - r1[j])); }
        }
#pragma unroll
        for (int ai = 0; ai < 2; ++ai)
#pragma unroll
            for (int m = 0; m < 4; ++m) { bf16_t* rowp = O + (size_t)(row0 + ai * HALF + m * 16) * DIN + col0;
#pragma unroll
                for (int bj = 0; bj < 2; ++bj) { f32x4 v0 = acc[ai][bj][m][0], v1 = acc[ai][bj][m][1];
                    if (sec == 0 || sec == 4) {
#pragma unroll
                        for (int j = 0; j < 4; ++j) { v0[j] = silu_f(v0[j]); v1[j] = silu_f(v1[j]); }
                    } else if (sec == 1 || sec == 2) {
#pragma unroll
                        for (int j = 0; j < 4; ++j) { v0[j] = oml[bj][0][j] * sigm_neg(v0[j]); v1[j] = oml[bj][1][j] * sigm_neg(v1[j]); }
                    }
                    u32x4 w; w.x = pk2(v0[0], v0[1]); w.y = pk2(v0[2], v0[3]); w.z = pk2(v1[0], v1[1]); w.w = pk2(v1[2], v1[3]);
                    *(u32x4*)(rowp + bj * HALF) = w; } }
    }
};
struct EpiOutProj {
    static constexpr bool PERM = true, AFTER_DRAIN = false;
    bf16_t* R1; const float* xp; const float* xs; const float* mod;
    __device__ __forceinline__ void operator()(const f32x4 (&acc)[2][2][4][2], const Unit& u, int wr, int wc, int fr, int fq) const {
        const int pm = u.pm; const float* xbase = pm < 32 ? xp + (size_t)pm * 256 * DMODEL : xs + (size_t)(pm - 32) * 256 * DMODEL;
        const int mi = pm < 32 ? 0 : 1 + ((pm - 32) >> 4);
        const int col0 = u.pn * BM + wc * 32 + 8 * fq; const float* g1 = mod + mi * MODW + 2048 + col0;
        f32x4 gv[2][2];
#pragma unroll
        for (int bj = 0; bj < 2; ++bj)
#pragma unroll
            for (int n = 0; n < 2; ++n) gv[bj][n] = *(const f32x4*)(g1 + bj * HALF + 4 * n);
#pragma unroll
        for (int ai = 0; ai < 2; ++ai)
#pragma unroll
            for (int m = 0; m < 4; ++m) { const int rl = wr * 64 + fr + ai * HALF + m * 16; const float* xr = xbase + (size_t)rl * DMODEL + col0; bf16_t* op = R1 + ((size_t)pm * 256 + rl) * DMODEL + col0;
#pragma unroll
                for (int bj = 0; bj < 2; ++bj) { const f32x4 x0 = *(const f32x4*)(xr + bj * HALF), x1 = *(const f32x4*)(xr + bj * HALF + 4);
                    const f32x4 v0 = x0 * DN_ALPHA + gv[bj][0] * acc[ai][bj][m][0], v1 = x1 * DN_ALPHA + gv[bj][1] * acc[ai][bj][m][1];
                    u32x4 w; w.x = pk2(v0[0], v0[1]); w.y = pk2(v0[2], v0[3]); w.z = pk2(v1[0], v1[1]); w.w = pk2(v1[2], v1[3]);
                    *(u32x4*)(op + bj * HALF) = w; }
                asm volatile("" ::: "memory"); }
    }
};
struct EpiGateUp {
    static constexpr bool PERM = true, AFTER_DRAIN = false;
    bf16_t* H;
    __device__ __forceinline__ void operator()(const f32x4 (&acc)[2][2][4][2], const Unit& u, int wr, int wc, int fr, int fq) const {
        const int row0 = u.pm * BM + wr * 64 + fr, col0 = u.pn * HALF + wc * 32 + 8 * fq;
#pragma unroll
        for (int ai = 0; ai < 2; ++ai)
#pragma unroll
            for (int m = 0; m < 4; ++m) { bf16_t* rowp = H + (size_t)(row0 + ai * HALF + m * 16) * DFF + col0;
                f32x4 v0, v1;
#pragma unroll
                for (int j = 0; j < 4; ++j) { v0[j] = silu_f(acc[ai][0][m][0][j]) * acc[ai][1][m][0][j]; v1[j] = silu_f(acc[ai][0][m][1][j]) * acc[ai][1][m][1][j]; }
                u32x4 w; w.x = pk2(v0[0], v0[1]); w.y = pk2(v0[2], v0[3]); w.z = pk2(v1[0], v1[1]); w.w = pk2(v1[2], v1[3]);
                *(u32x4*)rowp = w; }
    }
};
struct EpiDown {
    static constexpr bool PERM = false, AFTER_DRAIN = false;
    float* out; const bf16_t* X1; const float* mod;
    __device__ __forceinline__ void operator()(const f32x4 (&acc)[2][2][4][2], const Unit& u, int wr, int wc, int fr, int fq) const {
        const int pm = u.pm, mi = pm < 32 ? 0 : 1 + ((pm - 32) >> 4);
        const int col0 = u.pn * BM + wc * 32 + 4 * fq; const float* g2 = mod + mi * MODW + 5120 + col0;
        f32x4 gv[2][2];
#pragma unroll
        for (int bj = 0; bj < 2; ++bj)
#pragma unroll
            for (int n = 0; n < 2; ++n) gv[bj][n] = *(const f32x4*)(g2 + bj * HALF + n * 16);
#pragma unroll
        for (int ai = 0; ai < 2; ++ai)
#pragma unroll
            for (int m = 0; m < 4; ++m) { const size_t off = (size_t)(pm * BM + ai * HALF + wr * 64 + m * 16 + fr) * DMODEL + col0;
#pragma unroll
                for (int bj = 0; bj < 2; ++bj)
#pragma unroll
                    for (int n = 0; n < 2; ++n) { const u32x2 xv = *(const u32x2*)(X1 + off + bj * HALF + n * 16);
                        const f32x4 x1 = (f32x4){bflo(xv.x), bfhi(xv.x), bflo(xv.y), bfhi(xv.y)};
                        *(f32x4*)(out + off + bj * HALF + n * 16) = x1 * DN_ALPHA + gv[bj][n] * acc[ai][bj][m][n]; }
                asm volatile("" ::: "memory"); }
    }
};

template <class Epi, class Sched, bool ALIGN_EPI = false, bool SP2 = false>
__device__ __forceinline__ void gemm_phase(PG8_LAS unsigned char* lds, const Gemm g, const Sched& S, const Epi& E) {
    int tid_ = threadIdx.x; asm volatile("" : "+v"(tid_));
    const int tid = tid_, wid = __builtin_amdgcn_readfirstlane(tid >> 6), lane = tid & 63, wr = wid >> 2, wc = wid & 3, fr = lane & 15, fq = lane >> 4;
    const int K = g.K, nt = K / BK;
    unsigned voffA[2], voffB[2];
#pragma unroll
    for (int i = 0; i < 2; ++i) { int R, C; stage_rc(tid * 16 + i * 8192, R, C); const int Rb = Epi::PERM ? ((R & ~31) + perm32(R & 31)) : R;
        voffA[i] = (unsigned)(R * K + C) * 2u; voffB[i] = (unsigned)(Rb * K + C) * 2u; }
    const size_t kstep = (size_t)(BK * 2);
    const size_t hstep = (size_t)HALF * K * 2;
    const size_t tstep = 2 * hstep;
    const unsigned ldsw = (unsigned)wid * 1024u;
    const int aoff = lds_byte(wr * 64 + fr, fq * 8), boff = lds_byte(wc * 32 + fr, fq * 8);
#define PG8_SA(b, h) (((b) * 2 + (h)) * HTB)
#define PG8_SB(b, h) ((4 + (b) * 2 + (h)) * HTB)
#define PG8_STAGE(bufoff, gbase, voff) do { _Pragma("unroll") for (int _i = 0; _i < 2; ++_i) \
        __builtin_amdgcn_global_load_lds((const unsigned*)((const char*)(gbase) + (voff)[_i]), (PG8_LAS unsigned*)(lds + (bufoff) + ldsw + _i * 8192), 16, 0, 0); } while (0)
#define PG8_LDA(dst, b, h) do { _Pragma("unroll") for (int m = 0; m < 4; ++m) _Pragma("unroll") for (int k = 0; k < 2; ++k) dst[m][k] = *(const PG8_LAS bf16x8*)(lds + PG8_SA(b, h) + aoff + m * 2048 + k * 1024); } while (0)
#define PG8_LDB(dst, b, h) do { _Pragma("unroll") for (int n = 0; n < 2; ++n) _Pragma("unroll") for (int k = 0; k < 2; ++k) dst[n][k] = *(const PG8_LAS bf16x8*)(lds + PG8_SB(b, h) + boff + n * 2048 + k * 1024); } while (0)
#define PG8_MMA(ai, bj, At, Bt) do { __builtin_amdgcn_s_setprio(1); _Pragma("unroll") for (int m = 0; m < 4; ++m) _Pragma("unroll") for (int n = 0; n < 2; ++n) _Pragma("unroll") for (int k = 0; k < 2; ++k) \
        acc[ai][bj][m][n] = __builtin_amdgcn_mfma_f32_16x16x32_bf16(Bt[n][k], At[m][k], acc[ai][bj][m][n], 0, 0, 0); __builtin_amdgcn_s_setprio(0); } while (0)
#define PG8_WAIT_V(n) asm volatile("s_waitcnt vmcnt(" #n ")" ::: "memory")
#define PG8_WAIT_L(n) asm volatile("s_waitcnt lgkmcnt(" #n ")" ::: "memory")
#define PG8_BAR __builtin_amdgcn_s_barrier()
#define PG8_SCHED __builtin_amdgcn_sched_barrier(0)
    Unit cur, nxt; int ui = 0;
    if (!S.next(0, cur)) return;
    f32x4 acc[2][2][4][2];
#pragma unroll
    for (int a = 0; a < 2; ++a)
#pragma unroll
        for (int b = 0; b < 2; ++b)
#pragma unroll
            for (int m = 0; m < 4; ++m)
#pragma unroll
                for (int n = 0; n < 2; ++n) acc[a][b][m][n] = (f32x4){0.f, 0.f, 0.f, 0.f};
    bf16x8 At[4][2], B0[2][2], B1[2][2];
    const char* cA = (const char*)g.A + (size_t)cur.pm * tstep; const char* cB = (const char*)g.Bt + (size_t)cur.pn * tstep;
    S.a_ready(cur);
    if constexpr (SP2) {
        PG8_STAGE(PG8_SB(0, 0), cB, voffB); PG8_STAGE(PG8_SB(0, 1), cB + hstep, voffB); PG8_STAGE(PG8_SA(0, 0), cA, voffA); PG8_STAGE(PG8_SA(0, 1), cA + hstep, voffA);
        if (wr == 1) PG8_BAR;
        PG8_WAIT_V(2); PG8_BAR;
        PG8_STAGE(PG8_SB(1, 0), cB + kstep, voffB); PG8_STAGE(PG8_SA(1, 0), cA + kstep, voffA); PG8_STAGE(PG8_SB(1, 1), cB + hstep + kstep, voffB);
        PG8_WAIT_V(6); PG8_BAR;
    } else {
        PG8_STAGE(PG8_SB(0, 0), cB, voffB); PG8_STAGE(PG8_SA(0, 0), cA, voffA); PG8_STAGE(PG8_SB(0, 1), cB + hstep, voffB); PG8_STAGE(PG8_SA(0, 1), cA + hstep, voffA);
        if (wr == 1) PG8_BAR;
        PG8_WAIT_V(4); PG8_BAR;
        PG8_STAGE(PG8_SB(1, 0), cB + kstep, voffB); PG8_STAGE(PG8_SA(1, 0), cA + kstep, voffA); PG8_STAGE(PG8_SB(1, 1), cB + hstep + kstep, voffB);
        PG8_WAIT_V(6); PG8_BAR;
    }
    for (;;) {
        const bool has_next = S.next(ui + 1, nxt);
        const char* nA = has_next ? (const char*)g.A + (size_t)nxt.pm * tstep : cA; const char* nB = has_next ? (const char*)g.Bt + (size_t)nxt.pn * tstep : cB;
        for (int t = 0; t < nt; t += 2) {
            const bool last = (t == nt - 2);
            const char* a1 = cA + (size_t)(t + 1) * kstep;
            const char* a2 = last ? nA : cA + (size_t)(t + 2) * kstep; const char* b2 = last ? nB : cB + (size_t)(t + 2) * kstep;
            const char* a3 = a2 + kstep; const char* b3 = b2 + kstep;
            if (last && has_next) S.a_ready(nxt);
            if constexpr (SP2) {
            PG8_LDB(B0, 0, 0); PG8_LDB(B1, 0, 1); PG8_SCHED; PG8_LDA(At, 0, 0); PG8_STAGE(PG8_SA(1, 1), a1 + hstep, voffA);
            PG8_WAIT_V(8); PG8_WAIT_L(0); PG8_BAR; PG8_MMA(0, 0, At, B0); PG8_MMA(0, 1, At, B1); PG8_BAR; PG8_SCHED;
            PG8_LDA(At, 0, 1); PG8_STAGE(PG8_SB(0, 0), b2, voffB); PG8_STAGE(PG8_SB(0, 1), b2 + hstep, voffB); PG8_STAGE(PG8_SA(0, 0), a2, voffA);
            PG8_WAIT_V(8); PG8_WAIT_L(0); PG8_BAR; PG8_MMA(1, 0, At, B0); PG8_MMA(1, 1, At, B1); PG8_BAR; PG8_SCHED;
            PG8_LDB(B0, 1, 0); PG8_LDB(B1, 1, 1); PG8_SCHED; PG8_LDA(At, 1, 0); PG8_STAGE(PG8_SA(0, 1), a2 + hstep, voffA);
            PG8_WAIT_V(8); PG8_WAIT_L(0); PG8_BAR; PG8_MMA(0, 0, At, B0); PG8_MMA(0, 1, At, B1); PG8_BAR; PG8_SCHED;
            PG8_LDA(At, 1, 1); PG8_STAGE(PG8_SB(1, 0), b3, voffB); PG8_STAGE(PG8_SB(1, 1), b3 + hstep, voffB); PG8_STAGE(PG8_SA(1, 0), a3, voffA);
            PG8_WAIT_V(8); PG8_WAIT_L(0); PG8_BAR; PG8_MMA(1, 0, At, B0); PG8_MMA(1, 1, At, B1); PG8_BAR; PG8_SCHED;
            } else {
            PG8_LDB(B0, 0, 0); PG8_SCHED; PG8_LDA(At, 0, 0); PG8_STAGE(PG8_SA(1, 1), a1 + hstep, voffA);
            PG8_WAIT_L(8); PG8_BAR; PG8_WAIT_L(0); PG8_MMA(0, 0, At, B0); PG8_BAR; PG8_SCHED;
            PG8_LDB(B1, 0, 1); PG8_STAGE(PG8_SB(0, 0), b2, voffB);
            PG8_BAR; PG8_WAIT_L(0); PG8_MMA(0, 1, At, B1); PG8_BAR;
            PG8_LDA(At, 0, 1); PG8_STAGE(PG8_SA(0, 0), a2, voffA);
            PG8_BAR; PG8_WAIT_L(0); PG8_MMA(1, 0, At, B0); PG8_BAR; PG8_SCHED;
            PG8_STAGE(PG8_SB(0, 1), b2 + hstep, voffB);
            PG8_WAIT_V(6); PG8_BAR; PG8_MMA(1, 1, At, B1); PG8_BAR;
            PG8_LDB(B0, 1, 0); PG8_SCHED; PG8_LDA(At, 1, 0); PG8_STAGE(PG8_SA(0, 1), a2 + hstep, voffA);
            PG8_WAIT_L(8); PG8_BAR; PG8_WAIT_L(0); PG8_MMA(0, 0, At, B0); PG8_BAR; PG8_SCHED;
            PG8_LDB(B1, 1, 1); PG8_STAGE(PG8_SB(1, 0), b3, voffB);
            PG8_BAR; PG8_WAIT_L(0); PG8_MMA(0, 1, At, B1); PG8_BAR;
            PG8_LDA(At, 1, 1); PG8_STAGE(PG8_SA(1, 0), a3, voffA);
            PG8_BAR; PG8_WAIT_L(0); PG8_MMA(1, 0, At, B0); PG8_BAR; PG8_SCHED;
            PG8_STAGE(PG8_SB(1, 1), b3 + hstep, voffB);
            PG8_WAIT_V(6); PG8_BAR; PG8_MMA(1, 1, At, B1); PG8_BAR;
            }
        }
        if constexpr (ALIGN_EPI) { if (wr == 0) PG8_BAR; }
        if constexpr (!Epi::AFTER_DRAIN) { E(acc, cur, wr, wc, fr, fq); S.done(cur); }
        if (!has_next) break;
#pragma unroll
        for (int a = 0; a < 2; ++a)
#pragma unroll
            for (int b = 0; b < 2; ++b)
#pragma unroll
                for (int m = 0; m < 4; ++m)
#pragma unroll
                    for (int n = 0; n < 2; ++n) acc[a][b][m][n] = (f32x4){0.f, 0.f, 0.f, 0.f};
        cur = nxt; cA = nA; cB = nB; ++ui;
        if constexpr (ALIGN_EPI) { if (wr == 1) PG8_BAR; }
    }
    PG8_WAIT_V(0);
    if constexpr (!ALIGN_EPI) { if (wr == 0) PG8_BAR; }
    PG8_BAR;
    if constexpr (Epi::AFTER_DRAIN) { E.fused(acc, cur, wr, wc, fr, fq, lds, wid, lane); S.done(cur); }
#undef PG8_SA
#undef PG8_SB
#undef PG8_STAGE
#undef PG8_LDA
#undef PG8_LDB
#undef PG8_MMA
#undef PG8_WAIT_V
#undef PG8_WAIT_L
#undef PG8_BAR
#undef PG8_SCHED
}
}
constexpr int NWAVES = 8;
constexpr int DM = 1024, NP = 8192  , NS = 32768  , MTOK = NP + NS, TP = 256, TS = 4096;
constexpr int DIN_ = 3072, DFF_ = 2816, MODW_ = 6144, DREC = 512;
constexpr float LN_EPS = 1e-5f, RMS_EPS = 1e-6f;
constexpr size_t MiB = 1u << 20;
constexpr size_t WS_CTL = 0, CTL_ZERO_BYTES = 64 * 1024;
constexpr size_t WS_MOD = 1 * MiB;
constexpr size_t WS_WIN = 4 * MiB, WS_WOUT = 10 * MiB, WS_WGU = 12 * MiB, WS_WDN = 23 * MiB;
constexpr size_t WS_A = 32 * MiB;
constexpr size_t WS_B = 112 * MiB;
constexpr size_t WS_C = 352 * MiB;
constexpr size_t WS_END = 432 * MiB;
constexpr int CW_BAR = 4096;
constexpr int RING_OFF = 0, RING_BYTES = 131072;
constexpr int LDSCTL_OFF = RING_BYTES, MISC_OFF = LDSCTL_OFF + 320;
constexpr int LDS_BYTES = 147456;

#define GAS __attribute__((address_space(1)))
#define LAS __attribute__((address_space(3)))
typedef unsigned short bf16;
typedef unsigned v4u __attribute__((ext_vector_type(4)));
typedef unsigned v2u __attribute__((ext_vector_type(2)));
typedef float f32x4 __attribute__((ext_vector_type(4)));
typedef float f32x2 __attribute__((ext_vector_type(2)));
typedef float f32x16 __attribute__((ext_vector_type(16)));
typedef short bf16x8 __attribute__((ext_vector_type(8)));
typedef GAS unsigned gu32;
#define RLX_AGENT __ATOMIC_RELAXED, __HIP_MEMORY_SCOPE_AGENT
#define LDS_WAIT() asm volatile("s_waitcnt lgkmcnt(0)" ::: "memory")
#define VM_WAIT() asm volatile("s_waitcnt vmcnt(0)" ::: "memory")
using pg8::pk2; using pg8::bflo; using pg8::bfhi; using pg8::silu_f;

#define XB_TMO      128
#define XB_XCNT(j)  (256  + 64 * (j))
#define XB_XSUB(j)  (1280 + 64 * (j))
#define XB_XGEN(j)  (2304 + 64 * (j))
#define XB_TOP      3328
#define XB_TOPGEN   3392
#define XCD_BAR_WORDS 3456
#define XB_SPIN_CAP (1u << 18)

__device__ __forceinline__ unsigned xb_ld(unsigned* p)              { return __hip_atomic_load(p, __ATOMIC_RELAXED, __HIP_MEMORY_SCOPE_AGENT); }
__device__ __forceinline__ unsigned xb_add(unsigned* p, unsigned v) { return __hip_atomic_fetch_add(p, v, __ATOMIC_RELAXED, __HIP_MEMORY_SCOPE_AGENT); }
__device__ __forceinline__ unsigned xb_xcc_id() { return (unsigned)__builtin_amdgcn_s_getreg((3 << 11) | 20) & 0xFu; }
#define XB_SPIN(cond, bar) do { unsigned _sp = 0; while (cond) { __builtin_amdgcn_s_sleep(1); \
    if ((++_sp & 255u) == 0u) { if (xb_ld(&(bar)[XB_TMO])) break; if (_sp > XB_SPIN_CAP) { atomicAdd(&(bar)[XB_TMO], 1u); break; } } } } while (0)

struct XcdBarrier {
    unsigned* bar; unsigned x;
    volatile LAS unsigned* st;
};

__device__ __forceinline__ XcdBarrier xcd_barrier_post(unsigned* bar, volatile LAS unsigned* st) {
    XcdBarrier b; b.bar = bar; b.x = xb_xcc_id(); b.st = st;
    if (threadIdx.x == 0) (void)xb_add(&bar[XB_XCNT(b.x)], 1u);
    return b;
}
__device__ __forceinline__ void xcd_barrier_complete(unsigned* bar, unsigned x, unsigned& nloc, unsigned& nx) {
    const unsigned G = gridDim.x * gridDim.y * gridDim.z;
    unsigned sum, cnt, mine, sp = 0u;
    for (;;) {
        sum = 0u; cnt = 0u; mine = 0u;
#pragma unroll
        for (unsigned j = 0; j < 16; ++j) { const unsigned c = xb_ld(&bar[XB_XCNT(j)]); sum += c; cnt += (c > 0u) ? 1u : 0u; mine = (j == x) ? c : mine; }
        if (sum == G) break;
        __builtin_amdgcn_s_sleep(1);
        if ((++sp & 255u) == 0u) { if (xb_ld(&bar[XB_TMO])) break; if (sp > XB_SPIN_CAP) { atomicAdd(&bar[XB_TMO], 1u); break; } }
    }
    nloc = mine > 0u ? mine : 1u; nx = cnt > 0u ? cnt : 1u;
}

__device__ __forceinline__ void xcd_barrier(const XcdBarrier& b) {
    asm volatile("s_waitcnt vmcnt(0)" ::: "memory");
    __syncthreads();
    if (threadIdx.x == 0) {
        unsigned* bar = b.bar;
        __builtin_amdgcn_s_waitcnt(0);
        unsigned nloc = b.st[0], nx = b.st[1];
        if (nloc == 0u) { xcd_barrier_complete(bar, b.x, nloc, nx); b.st[0] = nloc; b.st[1] = nx; }
        const unsigned old = xb_add(&bar[XB_XSUB(b.x)], 1u);
        const unsigned gen = old / nloc;
        if (old + 1u == (gen + 1u) * nloc) {
            __builtin_amdgcn_fence(__ATOMIC_RELEASE, "agent");
            asm volatile("s_waitcnt vmcnt(0)" ::: "memory");
            const unsigned og = xb_add(&bar[XB_TOP], 1u);
            const unsigned tg = og / nx;
            if (og + 1u == (tg + 1u) * nx) xb_add(&bar[XB_TOPGEN], 1u);
            else XB_SPIN(xb_ld(&bar[XB_TOPGEN]) == tg, bar);
            __builtin_amdgcn_fence(__ATOMIC_ACQUIRE, "agent");
            xb_add(&bar[XB_XGEN(b.x)], 1u);
            asm volatile("s_waitcnt vmcnt(0)" ::: "memory");
        } else {
            XB_SPIN(xb_ld(&bar[XB_XGEN(b.x)]) == gen, bar);
            __builtin_amdgcn_fence(__ATOMIC_ACQUIRE, "agent");
            asm volatile("s_waitcnt vmcnt(0)" ::: "memory");
        }
    }
    __syncthreads();
}
struct Frame {
    LAS unsigned char* lds;
    volatile LAS unsigned* MISC;
    gu32* ctl;
    int tid, lane, wave, G;
    const float *xp, *xs, *st_f, *st_b, *c, *c_ctx, *w_mod, *b_mod, *w_in, *lbf, *lbb, *ng, *pool_w, *pool_scale, *w_out, *ln1g, *ln1b, *w_g, *w_u, *w_d, *ln2g, *ln2b;
    float* out;
    float* MOD;
    bf16 *WIN_T, *WOUT_T, *WGU_T, *WDN_T;
    bf16 *A, *B, *OF, *OB, *R1;
};
__device__ __forceinline__ float wave_sum(float v) {
#pragma unroll
    for (int o = 1; o < 64; o <<= 1) v += __shfl_xor(v, o);
    return v;
}
__device__ __forceinline__ int mod_index(int row) { return row < NP ? 0 : 1 + ((row - NP) >> 12); }

__device__ __forceinline__ void p0_mod(Frame& F) {
    if ((int)blockIdx.x >= 192) return;
    LAS float* SC = (LAS float*)(F.lds);
    LAS float* RED = (LAS float*)(F.lds + 36864);
    for (int i = F.tid; i < 9 * 1024; i += NWAVES * 64) { const int b = i >> 10, k = i & 1023; const float cv = (b == 0) ? F.c_ctx[k] : F.c[(b - 1) * 1024 + k]; SC[i] = silu_f(cv); }
    __syncthreads();
    for (int item = blockIdx.x; item < 192; item += F.G) {
        const int sr = F.lane >> 3, c4 = F.lane & 7, col = 32 * item + 4 * c4;
        f32x4 acc[9];
#pragma unroll
        for (int b = 0; b < 9; ++b) acc[b] = (f32x4){0.f, 0.f, 0.f, 0.f};
#pragma unroll 4
        for (int i = 0; i < 16; ++i) { const int k = 128 * F.wave + 8 * i + sr; const f32x4 w = *(const f32x4*)(F.w_mod + (size_t)k * MODW_ + col);
#pragma unroll
            for (int b = 0; b < 9; ++b) acc[b] += w * SC[b * 1024 + k]; }
#pragma unroll
        for (int b = 0; b < 9; ++b)
#pragma unroll
            for (int j = 0; j < 4; ++j) { float v = acc[b][j]; v += __shfl_xor(v, 8); v += __shfl_xor(v, 16); v += __shfl_xor(v, 32); acc[b][j] = v; }
        if (F.lane < 8) {
#pragma unroll
            for (int b = 0; b < 9; ++b) *(LAS f32x4*)(RED + (F.wave * 9 + b) * 32 + 4 * c4) = acc[b];
        }
        __syncthreads();
        if (F.tid < 288) { const int b = F.tid >> 5, cc = F.tid & 31; float s = 0.f;
#pragma unroll
            for (int w = 0; w < 8; ++w) s += RED[(w * 9 + b) * 32 + cc];
            F.MOD[b * MODW_ + 32 * item + cc] = s + F.b_mod[32 * item + cc]; }
        __syncthreads();
    }
}
__device__ __forceinline__ void p0_transpose_item(const float* W, int ldw, bf16* WT, int ldt, int k0, int n0, int drow0, LAS float* scr, int lane) {
#pragma unroll 8
    for (int i = 0; i < 32; ++i) { const int kk = 2 * i + (lane >> 5); scr[kk * 33 + (lane & 31)] = W[(size_t)(k0 + kk) * ldw + n0 + (lane & 31)]; }
    LDS_WAIT(); asm volatile("" ::: "memory");
    const int c = lane & 7;
#pragma unroll
    for (int j = 0; j < 4; ++j) { const int n = (lane >> 3) + 8 * j; const LAS float* s = scr + (8 * c) * 33 + n;
        v4u o; o.x = pk2(s[0 * 33], s[1 * 33]); o.y = pk2(s[2 * 33], s[3 * 33]); o.z = pk2(s[4 * 33], s[5 * 33]); o.w = pk2(s[6 * 33], s[7 * 33]);
        *(GAS v4u*)(WT + (size_t)(drow0 + n) * ldt + k0 + 8 * c) = o; }
    LDS_WAIT(); asm volatile("" ::: "memory");
}
__device__ __forceinline__ void p0_fold_item(Frame& F, int item, LAS float* T, int lane) {
    const int g = item >> 6, nb = (item >> 1) & 31, ii = item & 1, n0 = 32 * nb;
#pragma unroll 8
    for (int j2 = 0; j2 < 64; ++j2) { const int o = 2 * j2 + (lane >> 5), n = lane & 31; T[o * 32 + n] = F.pool_scale[g * 128 + o] * F.w_out[(size_t)(512 + g * 128 + o) * DM + n0 + n]; }
    LDS_WAIT(); asm volatile("" ::: "memory");
    const int i = 64 * ii + lane; const float* pw = F.pool_w + (size_t)(g * 128 + i) * 128;
    f32x4 acc[8];
#pragma unroll
    for (int q = 0; q < 8; ++q) acc[q] = (f32x4){0.f, 0.f, 0.f, 0.f};
    for (int o4 = 0; o4 < 32; ++o4) { const f32x4 a = *(const f32x4*)(pw + 4 * o4);
#pragma unroll
        for (int oo = 0; oo < 4; ++oo)
#pragma unroll
            for (int q = 0; q < 8; ++q) acc[q] += a[oo] * *(const LAS f32x4*)(T + (4 * o4 + oo) * 32 + 4 * q); }
#pragma unroll
    for (int q = 0; q < 8; ++q)
#pragma unroll
        for (int j = 0; j < 4; ++j) F.WOUT_T[(size_t)(n0 + 4 * q + j) * DM + 512 + g * 128 + i] = (bf16)(pk2(acc[q][j], 0.f) & 0xffffu);
    LDS_WAIT(); asm volatile("" ::: "memory");
}
__device__ __forceinline__ void p0_weights(Frame& F) {
    LAS float* scr = (LAS float*)(F.lds + RING_OFF + F.wave * 16384);
    const int gw = (int)blockIdx.x * NWAVES + F.wave, NGW = F.G * NWAVES;
    constexpr int I_IN = 16 * 96, I_OUT = 8 * 32, I_G = 16 * 88, I_D = 44 * 32, I_F = 256;
    constexpr int NITEMS = I_IN + I_OUT + 2 * I_G + I_D + I_F;
    for (int it = gw; it < NITEMS; it += NGW) {
        int r = it;
        if (r < I_F) { p0_fold_item(F, r, scr, F.lane); continue; } r -= I_F;
        if (r < I_IN) { const int kb = r / 96, nb = r % 96; p0_transpose_item(F.w_in, DIN_, F.WIN_T, DM, 64 * kb, 32 * nb, 32 * nb, scr, F.lane); continue; } r -= I_IN;
        if (r < I_OUT) { const int kb = r / 32, nb = r % 32; p0_transpose_item(F.w_out, DM, F.WOUT_T, DM, 64 * kb, 32 * nb, 32 * nb, scr, F.lane); continue; } r -= I_OUT;
        if (r < I_G) { const int kb = r / 88, nb = r % 88, n0 = 32 * nb; p0_transpose_item(F.w_g, DFF_, F.WGU_T, DM, 64 * kb, n0, 256 * (n0 >> 7) + (n0 & 127), scr, F.lane); continue; } r -= I_G;
        if (r < I_G) { const int kb = r / 88, nb = r % 88, n0 = 32 * nb; p0_transpose_item(F.w_u, DFF_, F.WGU_T, DM, 64 * kb, n0, 256 * (n0 >> 7) + 128 + (n0 & 127), scr, F.lane); continue; } r -= I_G;
        { const int kb = r / 32, nb = r % 32; p0_transpose_item(F.w_d, DM, F.WDN_T, DFF_, 64 * kb, 32 * nb, 32 * nb, scr, F.lane); }
    }
}
__device__ __forceinline__ void p1_h1(Frame& F) {
    const int gw = (int)blockIdx.x * NWAVES + F.wave, NGW = F.G * NWAVES;
    for (int u = gw; u < MTOK / 4; u += NGW) {
        const int row0 = 4 * u, mi = mod_index(row0); const float* sh = F.MOD + mi * MODW_ + 4 * F.lane; const float* sc = sh + 1024;
        f32x4 s[4], t[4];
#pragma unroll
        for (int j = 0; j < 4; ++j) { s[j] = *(const f32x4*)(sc + 256 * j) + 1.0f; t[j] = *(const f32x4*)(sh + 256 * j); }
#pragma unroll
        for (int rr = 0; rr < 4; ++rr) { const int row = row0 + rr; const float* xr = (row < NP ? F.xp + (size_t)row * DM : F.xs + (size_t)(row - NP) * DM) + 4 * F.lane; bf16* o = F.A + (size_t)row * DM + 4 * F.lane;
#pragma unroll
            for (int j = 0; j < 4; ++j) { const f32x4 v = *(const f32x4*)(xr + 256 * j) * s[j] + t[j]; v2u w; w.x = pk2(v[0], v[1]); w.y = pk2(v[2], v[3]); *(v2u*)(o + 256 * j) = w; } }
    }
}
constexpr int SC_QD = 0, SC_KI = 8704, SC_KET = 17408, SC_VT = 27648, SC_DEC = 37888, SC_BUF = 38400;
#define MFMA32(a, b, c) __builtin_amdgcn_mfma_f32_32x32x16_bf16((a), (b), (c), 0, 0, 0)
__device__ __forceinline__ int crow16(int reg, int h) { return (reg & 3) + 8 * (reg >> 2) + 4 * h; }
template <int S2> __device__ __forceinline__ bf16x8 pack8(const f32x16& x) {
    v4u p; p.x = pk2(x[8 * S2 + 0], x[8 * S2 + 1]); p.y = pk2(x[8 * S2 + 2], x[8 * S2 + 3]); p.z = pk2(x[8 * S2 + 4], x[8 * S2 + 5]); p.w = pk2(x[8 * S2 + 6], x[8 * S2 + 7]);
    return __builtin_bit_cast(bf16x8, p);
}
__device__ __forceinline__ bf16x8 lds8(const LAS unsigned char* p) { return *(const LAS bf16x8*)p; }

struct ScanRegs { unsigned q[8], k[8], v[8]; };
template <int DIR> __device__ __forceinline__ void scan_load(ScanRegs& R, const bf16* qp, const bf16* kp, const bf16* vp, int rowbase, int T, int n, int g) {
#pragma unroll
    for (int i = 0; i < 8; ++i) { const int c = 32 * n + 8 * g + i, t = DIR ? (T - 1 - c) : c; const size_t off = (size_t)(rowbase + t) * DIN_;
        R.q[i] = *(const unsigned*)(qp + off); R.k[i] = *(const unsigned*)(kp + off); R.v[i] = *(const unsigned*)(vp + off); }
}
__device__ __forceinline__ void scan_produce(const ScanRegs& R, LAS unsigned char* buf, int g, int cp, int lane) {
    float k0[8], k1[8], P0[8], P1[8]; float run0 = 1.f, run1 = 1.f;
#pragma unroll
    for (int i = 0; i < 8; ++i) { k0[i] = bflo(R.k[i]); k1[i] = bfhi(R.k[i]); run0 *= (1.f - k0[i]); run1 *= (1.f - k1[i]); P0[i] = run0; P1[i] = run1; }
    const float a1 = __shfl(run0, (lane - 16) & 63), a2 = __shfl(run0, (lane - 32) & 63), a3 = __shfl(run0, (lane - 48) & 63);
    const float b1 = __shfl(run1, (lane - 16) & 63), b2 = __shfl(run1, (lane - 32) & 63), b3 = __shfl(run1, (lane - 48) & 63);
    const float pre0 = (g >= 1 ? a1 : 1.f) * (g >= 2 ? a2 : 1.f) * (g >= 3 ? a3 : 1.f), pre1 = (g >= 1 ? b1 : 1.f) * (g >= 2 ? b2 : 1.f) * (g >= 3 ? b3 : 1.f);
    const float tot0 = __shfl(pre0 * run0, 48 + (lane & 15)), tot1 = __shfl(pre1 * run1, 48 + (lane & 15));
    const int d0 = 2 * cp, dl = d0 & 15, pos = (d0 & ~15) | (dl & 3) | (((dl >> 2) & 1) << 3) | (((dl >> 3) & 1) << 2);
    unsigned ke0[8], ke1[8];
#pragma unroll
    for (int i = 0; i < 8; ++i) {
        const float E0 = pre0 * P0[i], E1 = pre1 * P1[i], I0 = __builtin_amdgcn_rcpf(E0), I1 = __builtin_amdgcn_rcpf(E1);
        const float ki0 = k0[i] * I0, ki1 = k1[i] * I1;
        const int c = 8 * g + i;
        *(LAS unsigned*)(buf + SC_QD + c * 272 + pos * 2) = pk2(bflo(R.q[i]) * E0, bfhi(R.q[i]) * E1);
        *(LAS unsigned*)(buf + SC_KI + c * 272 + pos * 2) = pk2(ki0, ki1);
        const unsigned kk = pk2(ki0 * tot0, ki1 * tot1); ke0[i] = kk & 0xffffu; ke1[i] = kk >> 16;
    }
#pragma unroll
    for (int hh = 0; hh < 2; ++hh) {
        const int sp = (16 * (g >> 1) + 8 * hh + 4 * (g & 1)) * 2;
        v2u a, b, c, d;
        a.x = ke0[4 * hh] | (ke0[4 * hh + 1] << 16); a.y = ke0[4 * hh + 2] | (ke0[4 * hh + 3] << 16);
        b.x = ke1[4 * hh] | (ke1[4 * hh + 1] << 16); b.y = ke1[4 * hh + 2] | (ke1[4 * hh + 3] << 16);
        c.x = (R.v[4 * hh] & 0xffffu) | (R.v[4 * hh + 1] << 16); c.y = (R.v[4 * hh + 2] & 0xffffu) | (R.v[4 * hh + 3] << 16);
        d.x = (R.v[4 * hh] >> 16) | (R.v[4 * hh + 1] & 0xffff0000u); d.y = (R.v[4 * hh + 2] >> 16) | (R.v[4 * hh + 3] & 0xffff0000u);
        *(LAS v2u*)(buf + SC_KET + d0 * 80 + sp) = a; *(LAS v2u*)(buf + SC_KET + (d0 + 1) * 80 + sp) = b;
        *(LAS v2u*)(buf + SC_VT + d0 * 80 + sp) = c; *(LAS v2u*)(buf + SC_VT + (d0 + 1) * 80 + sp) = d;
    }
    if (g == 0) *(LAS f32x2*)(buf + SC_DEC + d0 * 4) = (f32x2){tot0, tot1};
}
template <int DIR> __device__ __forceinline__ void scan_item(Frame& F, int rowbase, int T, int h, const float* S0, float* Sout, bf16* O) {
    LAS unsigned char* lds = F.lds;
    const int N = T >> 5, lane = F.lane, wid = F.wave;
    if (wid >= 4) {
        const int pw = wid - 4, g = lane >> 4, cp = 16 * pw + (lane & 15);
        const bf16* qp = F.B + h * 128 + 2 * cp; const bf16* kp = qp + (DIR ? 1024 : 512); const bf16* vp = qp + 1536;
        ScanRegs cur, nxt;
        scan_load<DIR>(cur, qp, kp, vp, rowbase, T, 0, g);
        scan_load<DIR>(nxt, qp, kp, vp, rowbase, T, 1, g);
        scan_produce(cur, lds, g, cp, lane);
        __syncthreads();
        for (int n = 0; n < N; ++n) {
            if (n + 1 < N) {
                cur = nxt;
                if (n + 2 < N) scan_load<DIR>(nxt, qp, kp, vp, rowbase, T, n + 2, g);
                scan_produce(cur, lds + ((n + 1) & 1) * SC_BUF, g, cp, lane);
            }
            __syncthreads();
        }
    } else {
        const int w = wid, r = lane & 31, hh = lane >> 5;
        f32x16 S[4];
#pragma unroll
        for (int t = 0; t < 4; ++t)
#pragma unroll
            for (int i = 0; i < 16; ++i) S[t][i] = S0 ? S0[(size_t)(32 * t + crow16(i, hh)) * 128 + 32 * w + r] : 0.f;
        __syncthreads();
        for (int n = 0; n < N; ++n) {
            const LAS unsigned char* buf = lds + (n & 1) * SC_BUF;
            const LAS unsigned char* qd = buf + SC_QD + r * 272 + 16 * hh; const LAS unsigned char* ki = buf + SC_KI + r * 272 + 16 * hh;
            const LAS unsigned char* vt = buf + SC_VT + (32 * w + r) * 80 + 16 * hh;
            f32x16 X, o;
#pragma unroll
            for (int i = 0; i < 16; ++i) { X[i] = 0.f; o[i] = 0.f; }
#pragma unroll
            for (int kk = 0; kk < 8; ++kk) X = MFMA32(lds8(ki + 32 * kk), lds8(qd + 32 * kk), X);
#pragma unroll
            for (int t = 0; t < 4; ++t) { o = MFMA32(lds8(qd + 64 * t), pack8<0>(S[t]), o); o = MFMA32(lds8(qd + 64 * t + 32), pack8<1>(S[t]), o); }
#pragma unroll
            for (int i = 0; i < 16; ++i) X[i] = (crow16(i, hh) <= r) ? X[i] : 0.f;
            const bf16x8 v0 = lds8(vt), v1 = lds8(vt + 32);
            o = MFMA32(pack8<0>(X), v0, o); o = MFMA32(pack8<1>(X), v1, o);
#pragma unroll
            for (int t = 0; t < 4; ++t) {
#pragma unroll
                for (int g4 = 0; g4 < 4; ++g4) { const f32x4 dv = *(const LAS f32x4*)(buf + SC_DEC + (32 * t + 8 * g4 + 4 * hh) * 4);
#pragma unroll
                    for (int b = 0; b < 4; ++b) S[t][4 * g4 + b] *= dv[b]; }
                const LAS unsigned char* ke = buf + SC_KET + (32 * t + r) * 80 + 16 * hh;
                S[t] = MFMA32(lds8(ke), v0, S[t]); S[t] = MFMA32(lds8(ke + 32), v1, S[t]);
            }
            { const int cb = 32 * n + 4 * hh; size_t oo = (size_t)(rowbase + (DIR ? (T - 1 - cb) : cb)) * DREC + h * 128 + 32 * w + r;
              asm volatile("" : "+v"(oo));
              bf16* op = O + oo;
#pragma unroll
              for (int i = 0; i < 16; ++i) { const int cr = (i & 3) + 8 * (i >> 2); op[DIR ? -(cr * DREC) : (cr * DREC)] = (bf16)(pk2(o[i], 0.f) & 0xffffu); } }
            __syncthreads();
        }
        if (Sout) {
#pragma unroll
            for (int t = 0; t < 4; ++t)
#pragma unroll
                for (int i = 0; i < 16; ++i) Sout[(size_t)(32 * t + crow16(i, hh)) * 128 + 32 * w + r] = S[t][i];
        }
    }
}
__device__ __forceinline__ void unpack8(const v4u raw, float (&f)[8]) { f[0] = bflo(raw.x); f[1] = bfhi(raw.x); f[2] = bflo(raw.y); f[3] = bfhi(raw.y); f[4] = bflo(raw.z); f[5] = bfhi(raw.z); f[6] = bflo(raw.w); f[7] = bfhi(raw.w); }
__device__ __forceinline__ void pool_lat_item(Frame& F, int b, int gi, int r) {
    const int hw = 1 << gi;
    const int r0 = r - hw < 0 ? 0 : r - hw, r1 = r + hw > 64 ? 64 : r + hw;
    LAS float* V = (LAS float*)F.lds;
    const size_t tok0 = (size_t)NP + (size_t)b * TS;
    v4u ctr[2];
#pragma unroll
    for (int q = 0; q < 2; ++q) { const int idx = F.tid + 512 * q, c = idx >> 4, ch0 = (idx & 15) * 8;
        float a[8];
#pragma unroll
        for (int j = 0; j < 8; ++j) a[j] = 0.f;
        ctr[q] = (v4u){0u, 0u, 0u, 0u};
        for (int rp = r0; rp < r1; ++rp) { const v4u raw = *(const v4u*)(F.B + (tok0 + rp * 64 + c) * DIN_ + 2560 + gi * 128 + ch0); float f[8]; unpack8(raw, f);
#pragma unroll
            for (int j = 0; j < 8; ++j) a[j] += f[j];
            if (rp == r) ctr[q] = raw; }
        *(LAS f32x4*)(V + c * 128 + ch0) = (f32x4){a[0], a[1], a[2], a[3]}; *(LAS f32x4*)(V + c * 128 + ch0 + 4) = (f32x4){a[4], a[5], a[6], a[7]}; }
    __syncthreads();
#pragma unroll
    for (int q = 0; q < 2; ++q) { const int idx = F.tid + 512 * q, c = idx >> 4, ch0 = (idx & 15) * 8;
        const int c0 = c - hw < 0 ? 0 : c - hw, c1 = c + hw > 64 ? 64 : c + hw;
        f32x4 s0 = (f32x4){0.f, 0.f, 0.f, 0.f}, s1 = s0;
        for (int cq = c0; cq < c1; ++cq) { s0 += *(const LAS f32x4*)(V + cq * 128 + ch0); s1 += *(const LAS f32x4*)(V + cq * 128 + ch0 + 4); }
        const float inv = 1.0f / (float)((r1 - r0) * (c1 - c0)); float f[8]; unpack8(ctr[q], f);
        v4u o; o.x = pk2(s0[0] * inv - f[0], s0[1] * inv - f[1]); o.y = pk2(s0[2] * inv - f[2], s0[3] * inv - f[3]); o.z = pk2(s1[0] * inv - f[4], s1[1] * inv - f[5]); o.w = pk2(s1[2] * inv - f[6], s1[3] * inv - f[7]);
        *(v4u*)(F.A + (tok0 + r * 64 + c) * DM + 512 + gi * 128 + ch0) = o; }
    __syncthreads();
}
__device__ __forceinline__ void pool_ctx_item(Frame& F, int b, int gi, int seg) {
    const int hw = 1 << gi; const size_t tok0 = (size_t)b * TP;
#pragma unroll
    for (int q = 0; q < 2; ++q) { const int idx = F.tid + 512 * q, t = seg * 64 + (idx >> 4), ch0 = (idx & 15) * 8;
        const int t0 = t - hw < 0 ? 0 : t - hw, t1 = t + hw > TP ? TP : t + hw;
        float a[8];
#pragma unroll
        for (int j = 0; j < 8; ++j) a[j] = 0.f;
        v4u ctr = (v4u){0u, 0u, 0u, 0u};
        for (int tq = t0; tq < t1; ++tq) { const v4u raw = *(const v4u*)(F.B + (tok0 + tq) * DIN_ + 2560 + gi * 128 + ch0); float f[8]; unpack8(raw, f);
#pragma unroll
            for (int j = 0; j < 8; ++j) a[j] += f[j];
            if (tq == t) ctr = raw; }
        const float inv = 1.0f / (float)(t1 - t0); float f[8]; unpack8(ctr, f);
        v4u o; o.x = pk2(a[0] * inv - f[0], a[1] * inv - f[1]); o.y = pk2(a[2] * inv - f[2], a[3] * inv - f[3]); o.z = pk2(a[4] * inv - f[4], a[5] * inv - f[5]); o.w = pk2(a[6] * inv - f[6], a[7] * inv - f[7]);
        *(v4u*)(F.A + (tok0 + t) * DM + 512 + gi * 128 + ch0) = o; }
}
__device__ __forceinline__ void scan_dispatch(Frame& F, int it) {
    if (it < 64) { const int b = it >> 3, h = (it >> 1) & 3, dir = it & 1;
        if (dir) scan_item<1>(F, NP + b * TS, TS, h, F.st_b + (size_t)(b * 4 + h) * 16384, nullptr, F.OB); else scan_item<0>(F, NP + b * TS, TS, h, F.st_f + (size_t)(b * 4 + h) * 16384, nullptr, F.OF);
    } else { const int j = it - 64, b = j >> 3, h = (j >> 1) & 3, dir = j & 1;
        float* so = F.out + (size_t)MTOK * DM + (size_t)dir * (32 * 4 * 16384) + (size_t)(b * 4 + h) * 16384;
        if (dir) scan_item<1>(F, b * TP, TP, h, nullptr, so, F.OB); else scan_item<0>(F, b * TP, TP, h, nullptr, so, F.OF); }
}
__device__ __forceinline__ void pool_dispatch(Frame& F, int it) {
    if (it < 2048) pool_lat_item(F, it >> 8, (it >> 6) & 3, it & 63);
    else { const int j = it - 2048; pool_ctx_item(F, j >> 4, (j >> 2) & 3, j & 3); }
}
__device__ __forceinline__ void p3_scan_pool(Frame& F) {
    const int bx = blockIdx.x, G = F.G;
    if (G >= 128) {
        if (bx < 64) scan_dispatch(F, bx);
        else { const int np = G - 64;
            for (int it = 64 + (bx - 64); it < 320; it += np) scan_dispatch(F, it);
            for (int it = bx - 64; it < 2560; it += np) pool_dispatch(F, it); }
    } else {
        for (int it = bx; it < 320; it += G) scan_dispatch(F, it);
        for (int it = bx; it < 2560; it += G) pool_dispatch(F, it);
    }
}
__device__ __forceinline__ void p4_yrec(Frame& F) {
    const int gw = (int)blockIdx.x * NWAVES + F.wave, NGW = F.G * NWAVES, c0 = 8 * F.lane;
    const f32x4 n0 = *(const f32x4*)(F.ng + (c0 & 127)), n1 = *(const f32x4*)(F.ng + (c0 & 127) + 4);
    for (int row = gw; row < MTOK; row += NGW) {
        const v4u a = *(const v4u*)(F.OF + (size_t)row * DREC + c0), b = *(const v4u*)(F.OB + (size_t)row * DREC + c0), gg = *(const v4u*)(F.B + (size_t)row * DIN_ + 2048 + c0);
        float fa[8], fb[8], fg[8], o[8]; unpack8(a, fa); unpack8(b, fb); unpack8(gg, fg);
        float ss = 0.f;
#pragma unroll
        for (int j = 0; j < 8; ++j) { o[j] = fa[j] + fb[j]; ss += o[j] * o[j]; }
        ss += __shfl_xor(ss, 1); ss += __shfl_xor(ss, 2); ss += __shfl_xor(ss, 4); ss += __shfl_xor(ss, 8);
        const float rs = 1.0f / sqrtf(ss * (1.0f / 128.0f) + RMS_EPS);
        v4u w; w.x = pk2(o[0] * rs * n0[0] * fg[0], o[1] * rs * n0[1] * fg[1]); w.y = pk2(o[2] * rs * n0[2] * fg[2], o[3] * rs * n0[3] * fg[3]);
        w.z = pk2(o[4] * rs * n1[0] * fg[4], o[5] * rs * n1[1] * fg[5]); w.w = pk2(o[6] * rs * n1[2] * fg[6], o[7] * rs * n1[3] * fg[7]);
        *(v4u*)(F.A + (size_t)row * DM + c0) = w;
    }
}
__device__ __forceinline__ void p6_ln1(Frame& F) {
    const int gw = (int)blockIdx.x * NWAVES + F.wave, NGW = F.G * NWAVES;
    for (int row = gw; row < MTOK; row += NGW) {
        bf16* rp = F.R1 + (size_t)row * DM + 8 * F.lane; float v[16];
        { const v4u a = *(const v4u*)rp, b = *(const v4u*)(rp + 512); float fa[8], fb[8]; unpack8(a, fa); unpack8(b, fb);
#pragma unroll
          for (int j = 0; j < 8; ++j) { v[j] = fa[j]; v[8 + j] = fb[j]; } }
        float s = 0.f;
#pragma unroll
        for (int j = 0; j < 16; ++j) s += v[j];
        const float mean = wave_sum(s) * (1.0f / DM); float s2 = 0.f;
#pragma unroll
        for (int j = 0; j < 16; ++j) { v[j] -= mean; s2 += v[j] * v[j]; }
        const float rstd = 1.0f / sqrtf(wave_sum(s2) * (1.0f / DM) + LN_EPS);
        const float* md = F.MOD + mod_index(row) * MODW_ + 8 * F.lane;
#pragma unroll
        for (int hf = 0; hf < 2; ++hf) { const int cc = 8 * F.lane + 512 * hf; float x1[8], h2[8];
#pragma unroll
            for (int q = 0; q < 2; ++q) { const f32x4 g = *(const f32x4*)(F.ln1g + cc + 4 * q), bb = *(const f32x4*)(F.ln1b + cc + 4 * q);
                const f32x4 sh = *(const f32x4*)(md + 3072 + 512 * hf + 4 * q), sc = *(const f32x4*)(md + 4096 + 512 * hf + 4 * q);
#pragma unroll
                for (int j = 0; j < 4; ++j) { const float x = v[8 * hf + 4 * q + j] * rstd * g[j] + bb[j]; x1[4 * q + j] = x; h2[4 * q + j] = x * (1.0f + sc[j]) + sh[j]; } }
            v4u w1, w2; w1.x = pk2(x1[0], x1[1]); w1.y = pk2(x1[2], x1[3]); w1.z = pk2(x1[4], x1[5]); w1.w = pk2(x1[6], x1[7]);
            w2.x = pk2(h2[0], h2[1]); w2.y = pk2(h2[2], h2[3]); w2.z = pk2(h2[4], h2[5]); w2.w = pk2(h2[6], h2[7]);
            *(v4u*)(rp + 512 * hf) = w1; *(v4u*)(F.A + (size_t)row * DM + cc) = w2; }
    }
}
__device__ __forceinline__ void p9_ln2(Frame& F) {
    const int gw = (int)blockIdx.x * NWAVES + F.wave, NGW = F.G * NWAVES;
    f32x4 g[4], bb[4];
#pragma unroll
    for (int j = 0; j < 4; ++j) { g[j] = *(const f32x4*)(F.ln2g + 4 * F.lane + 256 * j); bb[j] = *(const f32x4*)(F.ln2b + 4 * F.lane + 256 * j); }
    for (int row = gw; row < MTOK; row += NGW) {
        float* xr = F.out + (size_t)row * DM + 4 * F.lane; f32x4 v[4]; float s = 0.f;
#pragma unroll
        for (int j = 0; j < 4; ++j) { v[j] = *(const f32x4*)(xr + 256 * j); s += (v[j][0] + v[j][1]) + (v[j][2] + v[j][3]); }
        const float mean = wave_sum(s) * (1.0f / DM); float s2 = 0.f;
#pragma unroll
        for (int j = 0; j < 4; ++j) { v[j] = v[j] - mean; s2 += (v[j][0] * v[j][0] + v[j][1] * v[j][1]) + (v[j][2] * v[j][2] + v[j][3] * v[j][3]); }
        const float rstd = 1.0f / sqrtf(wave_sum(s2) * (1.0f / DM) + LN_EPS);
#pragma unroll
        for (int j = 0; j < 4; ++j) *(f32x4*)(xr + 256 * j) = v[j] * rstd * g[j] + bb[j];
    }
}

struct Args { const float* in[22]; float* out; unsigned char* ws; };
__global__ void __launch_bounds__(NWAVES * 64, 2) hymba_fwd(Args args) {
    extern __shared__ __attribute__((aligned(16))) unsigned char lds[];
    Frame F;
    F.lds = (LAS unsigned char*)lds;
    F.MISC = (volatile LAS unsigned*)(F.lds + MISC_OFF);
    F.tid = threadIdx.x; F.lane = F.tid & 63; F.wave = __builtin_amdgcn_readfirstlane(F.tid >> 6); F.G = gridDim.x;
    unsigned char* ws = args.ws;
    F.ctl = (gu32*)(ws + WS_CTL);
    F.xp = args.in[0]; F.xs = args.in[1]; F.st_f = args.in[2]; F.st_b = args.in[3]; F.c = args.in[4]; F.c_ctx = args.in[5]; F.w_mod = args.in[6]; F.b_mod = args.in[7];
    F.w_in = args.in[8]; F.lbf = args.in[9]; F.lbb = args.in[10]; F.ng = args.in[11]; F.pool_w = args.in[12]; F.pool_scale = args.in[13]; F.w_out = args.in[14];
    F.ln1g = args.in[15]; F.ln1b = args.in[16]; F.w_g = args.in[17]; F.w_u = args.in[18]; F.w_d = args.in[19]; F.ln2g = args.in[20]; F.ln2b = args.in[21];
    F.out = args.out; F.MOD = (float*)(ws + WS_MOD);
    F.WIN_T = (bf16*)(ws + WS_WIN); F.WOUT_T = (bf16*)(ws + WS_WOUT); F.WGU_T = (bf16*)(ws + WS_WGU); F.WDN_T = (bf16*)(ws + WS_WDN);
    F.A = (bf16*)(ws + WS_A); F.B = (bf16*)(ws + WS_B); F.OF = (bf16*)(ws + WS_C); F.OB = F.OF + (size_t)MTOK * DREC; F.R1 = (bf16*)(ws + WS_C);
    for (int u = F.tid; u < (LDS_BYTES - LDSCTL_OFF) / 4; u += NWAVES * 64) ((LAS unsigned*)(F.lds + LDSCTL_OFF))[u] = 0u;
    __syncthreads();
    XcdBarrier bar = xcd_barrier_post((unsigned*)(F.ctl + CW_BAR), F.MISC + 8);

    p0_mod(F); p0_weights(F);
    xcd_barrier(bar);
    p1_h1(F);
    xcd_barrier(bar);
    { pg8::Gemm g{F.A, F.WIN_T, MTOK, DIN_, DM}; pg8::StaticOrder S; S.init(MTOK, DIN_, F.G, (int)blockIdx.x);
      pg8::EpiInProj E{F.B, F.lbf, F.lbb};
      pg8::gemm_phase<pg8::EpiInProj, pg8::StaticOrder, true, true>(F.lds + RING_OFF, g, S, E); }
    xcd_barrier(bar);
    p3_scan_pool(F);
    xcd_barrier(bar);
    p4_yrec(F);
    xcd_barrier(bar);
    { pg8::Gemm g{F.A, F.WOUT_T, MTOK, DM, DM}; pg8::StaticOrder S; S.init(MTOK, DM, F.G, (int)blockIdx.x);
      pg8::EpiOutProj E{F.R1, F.xp, F.xs, F.MOD};
      pg8::gemm_phase<pg8::EpiOutProj, pg8::StaticOrder, true, true>(F.lds + RING_OFF, g, S, E); }
    xcd_barrier(bar);
    p6_ln1(F);
    xcd_barrier(bar);
    { pg8::Gemm g{F.A, F.WGU_T, MTOK, 2 * DFF_, DM}; pg8::StaticOrder S; S.init(MTOK, 2 * DFF_, F.G, (int)blockIdx.x);
      pg8::EpiGateUp E{F.B};
      pg8::gemm_phase<pg8::EpiGateUp, pg8::StaticOrder, true, true>(F.lds + RING_OFF, g, S, E); }
    xcd_barrier(bar);
    { pg8::Gemm g{F.B, F.WDN_T, MTOK, DM, DFF_}; pg8::StaticOrder S; S.init(MTOK, DM, F.G, (int)blockIdx.x);
      pg8::EpiDown E{F.out, F.R1, F.MOD};
      pg8::gemm_phase<pg8::EpiDown, pg8::StaticOrder, true, true>(F.lds + RING_OFF, g, S, E); }
    xcd_barrier(bar);
    p9_ln2(F);
}

extern "C" void kernel_launch(void* const* d_in, const int* in_sizes, int n_in, void* d_out, int out_size, void* d_ws, size_t ws_size, hipStream_t stream) {
    static int grid = 0;
    if (grid == 0) {
        if (n_in != 22 || out_size != MTOK * DM + 2 * 32 * 4 * 16384 || ws_size < WS_END) { fprintf(stderr, "kernel_launch: unexpected shapes (n_in %d, out %d, ws %zu); nothing launched\n", n_in, out_size, ws_size); grid = -1; return; }
        int dev = 0, cus = 0, per_cu = 0;
        if (hipGetDevice(&dev) != hipSuccess || hipDeviceGetAttribute(&cus, hipDeviceAttributeMultiprocessorCount, dev) != hipSuccess) { grid = -1; return; }
        if (hipFuncSetAttribute((const void*)hymba_fwd, hipFuncAttributeMaxDynamicSharedMemorySize, LDS_BYTES) != hipSuccess) { fprintf(stderr, "kernel_launch: hipFuncSetAttribute failed\n"); grid = -1; return; }
        if (hipOccupancyMaxActiveBlocksPerMultiprocessor(&per_cu, (const void*)hymba_fwd, NWAVES * 64, LDS_BYTES) != hipSuccess || per_cu < 1) { fprintf(stderr, "kernel_launch: occupancy query says %d blocks per CU; nothing launched\n", per_cu); (void)hipGetLastError(); grid = -1; return; }
        grid = cus;
    }
    if (grid < 0) return;
    if (hipMemsetAsync((char*)d_ws + WS_CTL, 0, CTL_ZERO_BYTES, stream) != hipSuccess) return;
    Args a{};
    for (int i = 0; i < 22; ++i) a.in[i] = (const float*)d_in[i];
    a.out = (float*)d_out; a.ws = (unsigned char*)d_ws;
    hipLaunchKernelGGL(hymba_fwd, dim3(grid), dim3(NWAVES * 64), LDS_BYTES, stream, a);
}
```

```cpp
#include <hip/hip_runtime.h>
#include <cstdio>
#include <cstdint>
namespace pg8 {
#define PG8_LAS __attribute__((address_space(3)))
typedef unsigned short bf16_t;
typedef short bf16x8 __attribute__((ext_vector_type(8)));
typedef float f32x4 __attribute__((ext_vector_type(4)));
typedef unsigned u32x4 __attribute__((ext_vector_type(4)));
constexpr int BM = 256, BK = 64, HALF = 128, HTB = HALF * BK * 2  , STAGE_BYTES = 8 * HTB, NXCD = 8, WGM = 8;

__host__ __device__ __forceinline__ int lds_byte(int r, int c) { const int st = (r >> 4) * 2 + (c >> 5), rr = r & 15, cc = c & 31, ob = rr * 64 + cc * 2; return st * 1024 + (ob ^ (((ob >> 9) & 1) << 5)); }
__host__ __device__ __forceinline__ void stage_rc(int b, int& R, int& C) { const int st = b / 1024, sb = b % 1024, swz = sb ^ (((sb >> 9) & 1) << 5); R = (st >> 1) * 16 + swz / 64; C = (st & 1) * 32 + (swz % 64) / 2; }
__host__ __device__ __forceinline__ int perm32(int rho) { const int n = rho >> 4, i = rho & 15; return 8 * (i >> 2) + 4 * n + (i & 3); }

struct Unit { int pm, pn; };
struct Gemm { const bf16_t* A; const bf16_t* Bt; int M, N, K; };

struct StaticOrder {
    int nM, nN, nwg, G, c;
    __host__ __device__ void init(int M, int N, int G_, int c_) { nM = M / BM; nN = N / BM; nwg = nM * nN; G = G_; c = c_; }
    __host__ __device__ bool next(int i, Unit& u) const {
        const long L = (long)i * G + c; if (L >= nwg) return false;
        int wgid = (int)L; { const int q = nwg / NXCD, r = nwg % NXCD, xcd = wgid % NXCD, off = wgid / NXCD; wgid = (xcd < r ? xcd * (q + 1) : r * (q + 1) + (xcd - r) * q) + off; }
        const int nig = WGM * nN, gid = wgid / nig, fm = gid * WGM, gsz = (nM - fm) < WGM ? (nM - fm) : WGM;
        u.pm = fm + ((wgid % nig) % gsz); u.pn = (wgid % nig) / gsz; return true;
    }
    __device__ __forceinline__ void a_ready(const Unit&) const {}
    __device__ __forceinline__ void done(const Unit&) const {}
};

typedef __bf16 bf16x2v __attribute__((ext_vector_type(2)));
typedef float f32x2v __attribute__((ext_vector_type(2)));
typedef unsigned u32x2 __attribute__((ext_vector_type(2)));
__device__ __forceinline__ unsigned pk2(float lo, float hi) { f32x2v f = {lo, hi}; bf16x2v v = __builtin_convertvector(f, bf16x2v); return __builtin_bit_cast(unsigned, v); }
typedef int i32x8 __attribute__((ext_vector_type(8)));
typedef short bf16x16 __attribute__((ext_vector_type(16)));
__device__ __forceinline__ i32x8 cat8(bf16x8 a, bf16x8 b) { const bf16x16 c = __builtin_shufflevector(a, b, 0, 1, 2, 3, 4, 5, 6, 7, 8, 9, 10, 11, 12, 13, 14, 15); return __builtin_bit_cast(i32x8, c); }
__device__ __forceinline__ bf16x8 lo8(i32x8 v) { const bf16x16 c = __builtin_bit_cast(bf16x16, v); return __builtin_shufflevector(c, c, 0, 1, 2, 3, 4, 5, 6, 7); }
__device__ __forceinline__ bf16x8 hi8(i32x8 v) { const bf16x16 c = __builtin_bit_cast(bf16x16, v); return __builtin_shufflevector(c, c, 8, 9, 10, 11, 12, 13, 14, 15); }
__device__ __forceinline__ float clamp8(float x) { return __builtin_fminf(__builtin_fmaxf(x, -448.0f), 448.0f); }
__device__ __forceinline__ unsigned pk4f8(float a, float b, float c, float d) { int w = 0; w = __builtin_amdgcn_cvt_pk_fp8_f32(a, b, w, false); w = __builtin_amdgcn_cvt_pk_fp8_f32(c, d, w, true); return (unsigned)w; }
constexpr float F8_HID_SCALE = 8.0f, F8_WD_SCALE = 64.0f;
constexpr float F8_ACT_SCALE = 4.0f, F8_W_SCALE = 32.0f;
__device__ __forceinline__ float bflo(unsigned u) { return __builtin_bit_cast(float, u << 16); }
__device__ __forceinline__ float bfhi(unsigned u) { return __builtin_bit_cast(float, u & 0xffff0000u); }
__device__ __forceinline__ float sigm_neg(float z) { return __builtin_amdgcn_rcpf(1.0f + __expf(z)); }
__device__ __forceinline__ float silu_f(float x) { return x * __builtin_amdgcn_rcpf(1.0f + __expf(-x)); }
constexpr float DN_ALPHA = 1.189207115002721f;
constexpr int DMODEL = 1024, DIN = 3072, DFF = 2816, MODW = 6144, NPROMPT = 8192;

struct EpiInProj {
    static constexpr bool PERM = true, AFTER_DRAIN = false;
    bf16_t* O; const float* lbf; const float* lbb;
    __device__ __forceinline__ void operator()(const f32x4 (&acc)[2][2][4][2], const Unit& u, int wr, int wc, int fr, int fq) const {
        asm volatile("" : "+v"(fr), "+v"(fq));
        const int row0 = u.pm * BM + wr * 64 + fr, col0 = u.pn * BM + wc * 32 + 8 * fq, sec = u.pn >> 1;
        f32x4 oml[2][2];
#pragma unroll
        for (int bj = 0; bj < 2; ++bj)
#pragma unroll
            for (int n = 0; n < 2; ++n) oml[bj][n] = (f32x4){0.f, 0.f, 0.f, 0.f};
        if (sec == 1 || sec == 2) {
            const float* lb = (sec == 1) ? lbf : lbb; const int cs = (u.pn & 1) * 256 + wc * 32 + 8 * fq;
#pragma unroll
            for (int bj = 0; bj < 2; ++bj)
#pragma unroll
                for (int n = 0; n < 2; ++n) { const f32x4 r0 = *(const f32x4*)(lb + cs + bj * HALF + 4 * n), r1 = *(const f32x4*)(lb + 512 + cs + bj * HALF + 4 * n);
#pragma unroll
                    for (int j = 0; j < 4; ++j) oml[bj][n][j] = __builtin_amdgcn_rcpf(1.0f + __expf(r0[j] - r1[j])); }
        }
#pragma unroll
        for (int ai = 0; ai < 2; ++ai)
#pragma unroll
            for (int m = 0; m < 4; ++m) { bf16_t* rowp = O + (size_t)(row0 + ai * HALF + m * 16) * DIN + col0;
#pragma unroll
                for (int bj = 0; bj < 2; ++bj) { f32x4 v0 = acc[ai][bj][m][0], v1 = acc[ai][bj][m][1];
                    if (sec == 0 || sec == 4) {
#pragma unroll
                        for (int j = 0; j < 4; ++j) { v0[j] = silu_f(v0[j]); v1[j] = silu_f(v1[j]); }
                    } else if (sec == 1 || sec == 2) {
#pragma unroll
                        for (int j = 0; j < 4; ++j) { v0[j] = oml[bj][0][j] * sigm_neg(v0[j]); v1[j] = oml[bj][1][j] * sigm_neg(v1[j]); }
                    }
                    u32x4 w; w.x = pk2(v0[0], v0[1]); w.y = pk2(v0[2], v0[3]); w.z = pk2(v1[0], v1[1]); w.w = pk2(v1[2], v1[3]);
                    *(u32x4*)(rowp + bj * HALF) = w; } }
    }
};
struct EpiOutProj {
    static constexpr bool PERM = true, AFTER_DRAIN = false;
    bf16_t* R1; const float* xp; const float* xs; const float* mod;
    __device__ __forceinline__ void operator()(const f32x4 (&acc)[2][2][4][2], const Unit& u, int wr, int wc, int fr, int fq) const {
        asm volatile("" : "+v"(fr), "+v"(fq));
        const int pm = u.pm; const float* xbase = pm < 32 ? xp + (size_t)pm * 256 * DMODEL : xs + (size_t)(pm - 32) * 256 * DMODEL;
        const int mi = pm < 32 ? 0 : 1 + ((pm - 32) >> 4);
        const int col0 = u.pn * BM + wc * 32 + 8 * fq; const float* g1 = mod + mi * MODW + 2048 + col0;
        f32x4 gv[2][2];
#pragma unroll
        for (int bj = 0; bj < 2; ++bj)
#pragma unroll
            for (int n = 0; n < 2; ++n) gv[bj][n] = *(const f32x4*)(g1 + bj * HALF + 4 * n);
#pragma unroll
        for (int ai = 0; ai < 2; ++ai)
#pragma unroll
            for (int m = 0; m < 4; ++m) { const int rl = wr * 64 + fr + ai * HALF + m * 16; const float* xr = xbase + (size_t)rl * DMODEL + col0; bf16_t* op = R1 + ((size_t)pm * 256 + rl) * DMODEL + col0;
#pragma unroll
                for (int bj = 0; bj < 2; ++bj) { const f32x4 x0 = *(const f32x4*)(xr + bj * HALF), x1 = *(const f32x4*)(xr + bj * HALF + 4);
                    const f32x4 v0 = x0 * DN_ALPHA + gv[bj][0] * acc[ai][bj][m][0], v1 = x1 * DN_ALPHA + gv[bj][1] * acc[ai][bj][m][1];
                    u32x4 w; w.x = pk2(v0[0], v0[1]); w.y = pk2(v0[2], v0[3]); w.z = pk2(v1[0], v1[1]); w.w = pk2(v1[2], v1[3]);
                    *(u32x4*)(op + bj * HALF) = w; }
                asm volatile("" ::: "memory"); }
    }
};
struct EpiGateUp {
    static constexpr bool PERM = true, AFTER_DRAIN = false;
    unsigned char* H;
    __device__ __forceinline__ void operator()(const f32x4 (&acc)[2][2][4][2], const Unit& u, int wr, int wc, int fr, int fq) const {
        asm volatile("" : "+v"(fr), "+v"(fq));
        const int row0 = u.pm * BM + wr * 64 + fr, col0 = u.pn * HALF + wc * 32 + 8 * fq;
#pragma unroll
        for (int ai = 0; ai < 2; ++ai)
#pragma unroll
            for (int m = 0; m < 4; ++m) { unsigned char* rowp = H + (size_t)(row0 + ai * HALF + m * 16) * DFF + col0;
                f32x4 v0, v1;
#pragma unroll
                for (int j = 0; j < 4; ++j) { constexpr float sc = 1.0f / (F8_ACT_SCALE * F8_W_SCALE);
                    v0[j] = clamp8(silu_f(acc[ai][0][m][0][j] * sc) * (acc[ai][1][m][0][j] * (sc * F8_HID_SCALE))); v1[j] = clamp8(silu_f(acc[ai][0][m][1][j] * sc) * (acc[ai][1][m][1][j] * (sc * F8_HID_SCALE))); }
                u32x2 w; w.x = pk4f8(v0[0], v0[1], v0[2], v0[3]); w.y = pk4f8(v1[0], v1[1], v1[2], v1[3]);
                *(u32x2*)rowp = w; }
    }
};
struct EpiDown {
    static constexpr bool PERM = false, AFTER_DRAIN = false;
    float* out; const bf16_t* X1; const float* mod;
    __device__ __forceinline__ void operator()(const f32x4 (&acc)[2][2][4][2], const Unit& u, int wr, int wc, int fr, int fq) const {
        asm volatile("" : "+v"(fr), "+v"(fq));
        const int pm = u.pm, mi = pm < 32 ? 0 : 1 + ((pm - 32) >> 4);
        const int col0 = u.pn * BM + wc * 32 + 4 * fq; const float* g2 = mod + mi * MODW + 5120 + col0;
        f32x4 gv[2][2];
#pragma unroll
        for (int bj = 0; bj < 2; ++bj)
#pragma unroll
            for (int n = 0; n < 2; ++n) gv[bj][n] = *(const f32x4*)(g2 + bj * HALF + n * 16);
#pragma unroll
        for (int ai = 0; ai < 2; ++ai)
#pragma unroll
            for (int m = 0; m < 4; ++m) { const size_t off = (size_t)(pm * BM + ai * HALF + wr * 64 + m * 16 + fr) * DMODEL + col0;
#pragma unroll
                for (int bj = 0; bj < 2; ++bj)
#pragma unroll
                    for (int n = 0; n < 2; ++n) { const u32x2 xv = *(const u32x2*)(X1 + off + bj * HALF + n * 16);
                        const f32x4 x1 = (f32x4){bflo(xv.x), bfhi(xv.x), bflo(xv.y), bfhi(xv.y)};
                        *(f32x4*)(out + off + bj * HALF + n * 16) = x1 * DN_ALPHA + gv[bj][n] * (acc[ai][bj][m][n] * (1.0f / (F8_HID_SCALE * F8_WD_SCALE))); }
                asm volatile("" ::: "memory"); }
    }
};

template <class Epi, class Sched, bool ALIGN_EPI = false, bool SP2 = false, bool FP8 = false>
__device__ __forceinline__ void gemm_phase(PG8_LAS unsigned char* lds, const Gemm g, const Sched& S, const Epi& E) {
    int tid_ = threadIdx.x; asm volatile("" : "+v"(tid_));
    const int tid = tid_, wid = __builtin_amdgcn_readfirstlane(tid >> 6), lane = tid & 63, wr = wid >> 2, wc = wid & 3, fr = lane & 15, fq = lane >> 4;
    const int K = g.K, nt = K / BK;
    unsigned voffA[2], voffB[2];
#pragma unroll
    for (int i = 0; i < 2; ++i) { int R, C; stage_rc(tid * 16 + i * 8192, R, C); const int Rb = Epi::PERM ? ((R & ~31) + perm32(R & 31)) : R;
        voffA[i] = (unsigned)(R * K + C) * 2u; voffB[i] = (unsigned)(Rb * K + C) * 2u; }
    const size_t kstep = (size_t)(BK * 2);
    const size_t hstep = (size_t)HALF * K * 2;
    const size_t tstep = 2 * hstep;
    const unsigned ldsw = (unsigned)wid * 1024u;
    const int aoff = lds_byte(wr * 64 + fr, fq * 8), boff = lds_byte(wc * 32 + fr, fq * 8);
#define PG8_SA(b, h) (((b) * 2 + (h)) * HTB)
#define PG8_SB(b, h) ((4 + (b) * 2 + (h)) * HTB)
#define PG8_STAGE(bufoff, gbase, voff) do { _Pragma("unroll") for (int _i = 0; _i < 2; ++_i) \
        __builtin_amdgcn_global_load_lds((const unsigned*)((const char*)(gbase) + (voff)[_i]), (PG8_LAS unsigned*)(lds + (bufoff) + ldsw + _i * 8192), 16, 0, 0); } while (0)
#define PG8_LD16(off) (*(const PG8_LAS bf16x8*)(lds + (off)))
#define PG8_LDA(dst, b, h) do { _Pragma("unroll") for (int m = 0; m < 4; ++m) { if constexpr (FP8) dst##8[m] = cat8(PG8_LD16(PG8_SA(b, h) + aoff + m * 2048), PG8_LD16(PG8_SA(b, h) + aoff + m * 2048 + 1024)); \
        else { dst[m][0] = PG8_LD16(PG8_SA(b, h) + aoff + m * 2048); dst[m][1] = PG8_LD16(PG8_SA(b, h) + aoff + m * 2048 + 1024); } } } while (0)
#define PG8_LDB(dst, b, h) do { _Pragma("unroll") for (int n = 0; n < 2; ++n) { if constexpr (FP8) dst##8[n] = cat8(PG8_LD16(PG8_SB(b, h) + boff + n * 2048), PG8_LD16(PG8_SB(b, h) + boff + n * 2048 + 1024)); \
        else { dst[n][0] = PG8_LD16(PG8_SB(b, h) + boff + n * 2048); dst[n][1] = PG8_LD16(PG8_SB(b, h) + boff + n * 2048 + 1024); } } } while (0)
#define PG8_MMA(ai, bj, At, Bt) do { __builtin_amdgcn_s_setprio(1); _Pragma("unroll") for (int m = 0; m < 4; ++m) _Pragma("unroll") for (int n = 0; n < 2; ++n) { \
        if constexpr (FP8) { asm volatile("v_mfma_scale_f32_16x16x128_f8f6f4 %0, %1, %2, %0, %3, %3 op_sel_hi:[0,0,0]" : "+v"(acc[ai][bj][m][n]) : "v"(Bt##8[n]), "v"(At##8[m]), "v"(f8scale)); } \
        else { _Pragma("unroll") for (int k = 0; k < 2; ++k) acc[ai][bj][m][n] = __builtin_amdgcn_mfma_f32_16x16x32_bf16(Bt[n][k], At[m][k], acc[ai][bj][m][n], 0, 0, 0); } } __builtin_amdgcn_s_setprio(0); } while (0)
#define PG8_WAIT_V(n) asm volatile("s_waitcnt vmcnt(" #n ")" ::: "memory")
#define PG8_WAIT_L(n) asm volatile("s_waitcnt lgkmcnt(" #n ")" ::: "memory")
#define PG8_BAR __builtin_amdgcn_s_barrier()
#define PG8_SCHED __builtin_amdgcn_sched_barrier(0)
    Unit cur, nxt; int ui = 0;
    if (!S.next(0, cur)) return;
    f32x4 acc[2][2][4][2];
#pragma unroll
    for (int a = 0; a < 2; ++a)
#pragma unroll
        for (int b = 0; b < 2; ++b)
#pragma unroll
            for (int m = 0; m < 4; ++m)
#pragma unroll
                for (int n = 0; n < 2; ++n) acc[a][b][m][n] = (f32x4){0.f, 0.f, 0.f, 0.f};
    bf16x8 At[4][2], B0[2][2], B1[2][2]; i32x8 At8[4], B08[2], B18[2];
    const int f8scale = 0x7f7f7f7f;
    const char* cA = (const char*)g.A + (size_t)cur.pm * tstep; const char* cB = (const char*)g.Bt + (size_t)cur.pn * tstep;
    S.a_ready(cur);
    if constexpr (SP2) {
        PG8_STAGE(PG8_SB(0, 0), cB, voffB); PG8_STAGE(PG8_SB(0, 1), cB + hstep, voffB); PG8_STAGE(PG8_SA(0, 0), cA, voffA); PG8_STAGE(PG8_SA(0, 1), cA + hstep, voffA);
        if (wr == 1) PG8_BAR;
        PG8_WAIT_V(2); PG8_BAR;
        PG8_STAGE(PG8_SB(1, 0), cB + kstep, voffB); PG8_STAGE(PG8_SA(1, 0), cA + kstep, voffA); PG8_STAGE(PG8_SB(1, 1), cB + hstep + kstep, voffB);
        PG8_WAIT_V(6); PG8_BAR;
    } else {
        PG8_STAGE(PG8_SB(0, 0), cB, voffB); PG8_STAGE(PG8_SA(0, 0), cA, voffA); PG8_STAGE(PG8_SB(0, 1), cB + hstep, voffB); PG8_STAGE(PG8_SA(0, 1), cA + hstep, voffA);
        if (wr == 1) PG8_BAR;
        PG8_WAIT_V(4); PG8_BAR;
        PG8_STAGE(PG8_SB(1, 0), cB + kstep, voffB); PG8_STAGE(PG8_SA(1, 0), cA + kstep, voffA); PG8_STAGE(PG8_SB(1, 1), cB + hstep + kstep, voffB);
        PG8_WAIT_V(6); PG8_BAR;
    }
    for (;;) {
        const bool has_next = S.next(ui + 1, nxt);
        const char* nA = has_next ? (const char*)g.A + (size_t)nxt.pm * tstep : cA; const char* nB = has_next ? (const char*)g.Bt + (size_t)nxt.pn * tstep : cB;
#pragma unroll 1
        for (int t = 0; t < nt; t += 2) {
            const bool last = (t == nt - 2);
            const char* a1 = cA + (size_t)(t + 1) * kstep;
            const char* a2 = last ? nA : cA + (size_t)(t + 2) * kstep; const char* b2 = last ? nB : cB + (size_t)(t + 2) * kstep;
            const char* a3 = a2 + kstep; const char* b3 = b2 + kstep;
            if (last && has_next) S.a_ready(nxt);
            if constexpr (SP2) {
            PG8_LDB(B0, 0, 0); PG8_LDB(B1, 0, 1); PG8_SCHED; PG8_LDA(At, 0, 0); PG8_STAGE(PG8_SA(1, 1), a1 + hstep, voffA);
            PG8_WAIT_V(8); PG8_WAIT_L(0); PG8_BAR; PG8_MMA(0, 0, At, B0); PG8_MMA(0, 1, At, B1); PG8_BAR; PG8_SCHED;
            PG8_LDA(At, 0, 1); PG8_STAGE(PG8_SB(0, 0), b2, voffB); PG8_STAGE(PG8_SB(0, 1), b2 + hstep, voffB); PG8_STAGE(PG8_SA(0, 0), a2, voffA);
            PG8_WAIT_V(8); PG8_WAIT_L(0); PG8_BAR; PG8_MMA(1, 0, At, B0); PG8_MMA(1, 1, At, B1); PG8_BAR; PG8_SCHED;
            PG8_LDB(B0, 1, 0); PG8_LDB(B1, 1, 1); PG8_SCHED; PG8_LDA(At, 1, 0); PG8_STAGE(PG8_SA(0, 1), a2 + hstep, voffA);
            PG8_WAIT_V(8); PG8_WAIT_L(0); PG8_BAR; PG8_MMA(0, 0, At, B0); PG8_MMA(0, 1, At, B1); PG8_BAR; PG8_SCHED;
            PG8_LDA(At, 1, 1); PG8_STAGE(PG8_SB(1, 0), b3, voffB); PG8_STAGE(PG8_SB(1, 1), b3 + hstep, voffB); PG8_STAGE(PG8_SA(1, 0), a3, voffA);
            PG8_WAIT_V(8); PG8_WAIT_L(0); PG8_BAR; PG8_MMA(1, 0, At, B0); PG8_MMA(1, 1, At, B1); PG8_BAR; PG8_SCHED;
            } else {
            PG8_LDB(B0, 0, 0); PG8_SCHED; PG8_LDA(At, 0, 0); PG8_STAGE(PG8_SA(1, 1), a1 + hstep, voffA);
            PG8_WAIT_L(8); PG8_BAR; PG8_WAIT_L(0); PG8_MMA(0, 0, At, B0); PG8_BAR; PG8_SCHED;
            PG8_LDB(B1, 0, 1); PG8_STAGE(PG8_SB(0, 0), b2, voffB);
            PG8_BAR; PG8_WAIT_L(0); PG8_MMA(0, 1, At, B1); PG8_BAR;
            PG8_LDA(At, 0, 1); PG8_STAGE(PG8_SA(0, 0), a2, voffA);
            PG8_BAR; PG8_WAIT_L(0); PG8_MMA(1, 0, At, B0); PG8_BAR; PG8_SCHED;
            PG8_STAGE(PG8_SB(0, 1), b2 + hstep, voffB);
            PG8_WAIT_V(6); PG8_BAR; PG8_MMA(1, 1, At, B1); PG8_BAR;
            PG8_LDB(B0, 1, 0); PG8_SCHED; PG8_LDA(At, 1, 0); PG8_STAGE(PG8_SA(0, 1), a2 + hstep, voffA);
            PG8_WAIT_L(8); PG8_BAR; PG8_WAIT_L(0); PG8_MMA(0, 0, At, B0); PG8_BAR; PG8_SCHED;
            PG8_LDB(B1, 1, 1); PG8_STAGE(PG8_SB(1, 0), b3, voffB);
            PG8_BAR; PG8_WAIT_L(0); PG8_MMA(0, 1, At, B1); PG8_BAR;
            PG8_LDA(At, 1, 1); PG8_STAGE(PG8_SA(1, 0), a3, voffA);
            PG8_BAR; PG8_WAIT_L(0); PG8_MMA(1, 0, At, B0); PG8_BAR; PG8_SCHED;
            PG8_STAGE(PG8_SB(1, 1), b3 + hstep, voffB);
            PG8_WAIT_V(6); PG8_BAR; PG8_MMA(1, 1, At, B1); PG8_BAR;
            }
        }
        if constexpr (ALIGN_EPI) { if (wr == 0) PG8_BAR; }
        if constexpr (FP8) { asm volatile("s_nop 15\n\ts_nop 15" ::: "memory"); }
        if constexpr (!Epi::AFTER_DRAIN) { E(acc, cur, wr, wc, fr, fq); S.done(cur); }
        if (!has_next) break;
#pragma unroll
        for (int a = 0; a < 2; ++a)
#pragma unroll
            for (int b = 0; b < 2; ++b)
#pragma unroll
                for (int m = 0; m < 4; ++m)
#pragma unroll
                    for (int n = 0; n < 2; ++n) acc[a][b][m][n] = (f32x4){0.f, 0.f, 0.f, 0.f};
        cur = nxt; cA = nA; cB = nB; ++ui;
        if constexpr (ALIGN_EPI) { if (wr == 1) PG8_BAR; }
    }
    PG8_WAIT_V(0);
    if constexpr (!ALIGN_EPI) { if (wr == 0) PG8_BAR; }
    PG8_BAR;
    if constexpr (Epi::AFTER_DRAIN) { E.fused(acc, cur, wr, wc, fr, fq, lds, wid, lane); S.done(cur); }
#undef PG8_SA
#undef PG8_SB
#undef PG8_STAGE
#undef PG8_LDA
#undef PG8_LDB
#undef PG8_MMA
#undef PG8_WAIT_V
#undef PG8_WAIT_L
#undef PG8_BAR
#undef PG8_SCHED
}
}
constexpr int NWAVES = 8;
constexpr int DM = 1024, NP = 8192  , NS = 32768  , MTOK = NP + NS, TP = 256, TS = 4096;
constexpr int DIN_ = 3072, DFF_ = 2816, MODW_ = 6144, DREC = 512;
constexpr float LN_EPS = 1e-5f, RMS_EPS = 1e-6f;
constexpr size_t MiB = 1u << 20;
constexpr size_t WS_CTL = 0, CTL_ZERO_BYTES = 64 * 1024;
constexpr size_t WS_MOD = 1 * MiB;
constexpr size_t WS_WIN = 4 * MiB, WS_WOUT = 10 * MiB, WS_WGU = 12 * MiB, WS_WDN = 23 * MiB;
constexpr size_t WS_A = 32 * MiB;
constexpr size_t WS_B = 112 * MiB;
constexpr size_t WS_C = 352 * MiB;
constexpr size_t WS_END = 432 * MiB;
constexpr int CW_BAR = 4096;
constexpr int RING_OFF = 0, RING_BYTES = 131072;
constexpr int LDSCTL_OFF = RING_BYTES, MISC_OFF = LDSCTL_OFF + 320;
constexpr int LDS_BYTES = 147456;

#define GAS __attribute__((address_space(1)))
#define LAS __attribute__((address_space(3)))
typedef unsigned short bf16;
typedef unsigned v4u __attribute__((ext_vector_type(4)));
typedef unsigned v2u __attribute__((ext_vector_type(2)));
typedef float f32x4 __attribute__((ext_vector_type(4)));
typedef float f32x2 __attribute__((ext_vector_type(2)));
typedef float f32x16 __attribute__((ext_vector_type(16)));
typedef short bf16x8 __attribute__((ext_vector_type(8)));
typedef GAS unsigned gu32;
#define RLX_AGENT __ATOMIC_RELAXED, __HIP_MEMORY_SCOPE_AGENT
#define LDS_WAIT() asm volatile("s_waitcnt lgkmcnt(0)" ::: "memory")
#define VM_WAIT() asm volatile("s_waitcnt vmcnt(0)" ::: "memory")
using pg8::pk2; using pg8::bflo; using pg8::bfhi; using pg8::silu_f;

#define XB_TMO      128
#define XB_XCNT(j)  (256  + 64 * (j))
#define XB_XSUB(j)  (1280 + 64 * (j))
#define XB_XGEN(j)  (2304 + 64 * (j))
#define XB_TOP      3328
#define XB_TOPGEN   3392
#define XCD_BAR_WORDS 3456
#define XB_SPIN_CAP (1u << 18)

__device__ __forceinline__ unsigned xb_ld(unsigned* p)              { return __hip_atomic_load(p, __ATOMIC_RELAXED, __HIP_MEMORY_SCOPE_AGENT); }
__device__ __forceinline__ unsigned xb_add(unsigned* p, unsigned v) { return __hip_atomic_fetch_add(p, v, __ATOMIC_RELAXED, __HIP_MEMORY_SCOPE_AGENT); }
__device__ __forceinline__ unsigned xb_xcc_id() { return (unsigned)__builtin_amdgcn_s_getreg((3 << 11) | 20) & 0xFu; }
#define XB_SPIN(cond, bar) do { unsigned _sp = 0; while (cond) { __builtin_amdgcn_s_sleep(1); \
    if ((++_sp & 255u) == 0u) { if (xb_ld(&(bar)[XB_TMO])) break; if (_sp > XB_SPIN_CAP) { atomicAdd(&(bar)[XB_TMO], 1u); break; } } } } while (0)

struct XcdBarrier {
    unsigned* bar; unsigned x;
    volatile LAS unsigned* st;
};

__device__ __forceinline__ XcdBarrier xcd_barrier_post(unsigned* bar, volatile LAS unsigned* st) {
    XcdBarrier b; b.bar = bar; b.x = xb_xcc_id(); b.st = st;
    if (threadIdx.x == 0) (void)xb_add(&bar[XB_XCNT(b.x)], 1u);
    return b;
}
__device__ __forceinline__ void xcd_barrier_complete(unsigned* bar, unsigned x, unsigned& nloc, unsigned& nx) {
    const unsigned G = gridDim.x * gridDim.y * gridDim.z;
    unsigned sum, cnt, mine, sp = 0u;
    for (;;) {
        sum = 0u; cnt = 0u; mine = 0u;
#pragma unroll
        for (unsigned j = 0; j < 16; ++j) { const unsigned c = xb_ld(&bar[XB_XCNT(j)]); sum += c; cnt += (c > 0u) ? 1u : 0u; mine = (j == x) ? c : mine; }
        if (sum == G) break;
        __builtin_amdgcn_s_sleep(1);
        if ((++sp & 255u) == 0u) { if (xb_ld(&bar[XB_TMO])) break; if (sp > XB_SPIN_CAP) { atomicAdd(&bar[XB_TMO], 1u); break; } }
    }
    nloc = mine > 0u ? mine : 1u; nx = cnt > 0u ? cnt : 1u;
}

__device__ __forceinline__ void xcd_barrier(const XcdBarrier& b) {
    asm volatile("s_waitcnt vmcnt(0)" ::: "memory");
    __syncthreads();
    if (threadIdx.x == 0) {
        unsigned* bar = b.bar;
        __builtin_amdgcn_s_waitcnt(0);
        unsigned nloc = b.st[0], nx = b.st[1];
        if (nloc == 0u) { xcd_barrier_complete(bar, b.x, nloc, nx); b.st[0] = nloc; b.st[1] = nx; }
        const unsigned old = xb_add(&bar[XB_XSUB(b.x)], 1u);
        const unsigned gen = old / nloc;
        if (old + 1u == (gen + 1u) * nloc) {
            __builtin_amdgcn_fence(__ATOMIC_RELEASE, "agent");
            asm volatile("s_waitcnt vmcnt(0)" ::: "memory");
            const unsigned og = xb_add(&bar[XB_TOP], 1u);
            const unsigned tg = og / nx;
            if (og + 1u == (tg + 1u) * nx) xb_add(&bar[XB_TOPGEN], 1u);
            else XB_SPIN(xb_ld(&bar[XB_TOPGEN]) == tg, bar);
            __builtin_amdgcn_fence(__ATOMIC_ACQUIRE, "agent");
            xb_add(&bar[XB_XGEN(b.x)], 1u);
            asm volatile("s_waitcnt vmcnt(0)" ::: "memory");
        } else {
            XB_SPIN(xb_ld(&bar[XB_XGEN(b.x)]) == gen, bar);
            __builtin_amdgcn_fence(__ATOMIC_ACQUIRE, "agent");
            asm volatile("s_waitcnt vmcnt(0)" ::: "memory");
        }
    }
    __syncthreads();
}
struct Frame {
    LAS unsigned char* lds;
    volatile LAS unsigned* MISC;
    gu32* ctl;
    int tid, lane, wave, G;
    const float *xp, *xs, *st_f, *st_b, *c, *c_ctx, *w_mod, *b_mod, *w_in, *lbf, *lbb, *ng, *pool_w, *pool_scale, *w_out, *ln1g, *ln1b, *w_g, *w_u, *w_d, *ln2g, *ln2b;
    float* out;
    float* MOD;
    bf16 *WIN_T, *WOUT_T, *WGU_T, *WDN_T;
    bf16 *A, *B, *OF, *OB, *R1;
};
__device__ __forceinline__ float wave_sum(float v) {
#pragma unroll
    for (int o = 1; o < 64; o <<= 1) v += __shfl_xor(v, o);
    return v;
}
__device__ __forceinline__ int mod_index(int row) { return row < NP ? 0 : 1 + ((row - NP) >> 12); }

__device__ __forceinline__ void p0_mod(Frame& F) {
    if ((int)blockIdx.x >= 192) return;
    LAS float* SC = (LAS float*)(F.lds);
    LAS float* RED = (LAS float*)(F.lds + 36864);
    for (int i = F.tid; i < 9 * 1024; i += NWAVES * 64) { const int b = i >> 10, k = i & 1023; const float cv = (b == 0) ? F.c_ctx[k] : F.c[(b - 1) * 1024 + k]; SC[i] = silu_f(cv); }
    __syncthreads();
    for (int item = blockIdx.x; item < 192; item += F.G) {
        const int sr = F.lane >> 3, c4 = F.lane & 7, col = 32 * item + 4 * c4;
        f32x4 acc[9];
#pragma unroll
        for (int b = 0; b < 9; ++b) acc[b] = (f32x4){0.f, 0.f, 0.f, 0.f};
#pragma unroll 4
        for (int i = 0; i < 16; ++i) { const int k = 128 * F.wave + 8 * i + sr; const f32x4 w = *(const f32x4*)(F.w_mod + (size_t)k * MODW_ + col);
#pragma unroll
            for (int b = 0; b < 9; ++b) acc[b] += w * SC[b * 1024 + k]; }
#pragma unroll
        for (int b = 0; b < 9; ++b)
#pragma unroll
            for (int j = 0; j < 4; ++j) { float v = acc[b][j]; v += __shfl_xor(v, 8); v += __shfl_xor(v, 16); v += __shfl_xor(v, 32); acc[b][j] = v; }
        if (F.lane < 8) {
#pragma unroll
            for (int b = 0; b < 9; ++b) *(LAS f32x4*)(RED + (F.wave * 9 + b) * 32 + 4 * c4) = acc[b];
        }
        __syncthreads();
        if (F.tid < 288) { const int b = F.tid >> 5, cc = F.tid & 31; float s = 0.f;
#pragma unroll
            for (int w = 0; w < 8; ++w) s += RED[(w * 9 + b) * 32 + cc];
            F.MOD[b * MODW_ + 32 * item + cc] = s + F.b_mod[32 * item + cc]; }
        __syncthreads();
    }
}
__device__ __forceinline__ void p0_transpose_item(const float* W, int ldw, bf16* WT, int ldt, int k0, int n0, int drow0, LAS float* scr, int lane) {
#pragma unroll 8
    for (int i = 0; i < 32; ++i) { const int kk = 2 * i + (lane >> 5); scr[kk * 33 + (lane & 31)] = W[(size_t)(k0 + kk) * ldw + n0 + (lane & 31)]; }
    LDS_WAIT(); asm volatile("" ::: "memory");
    const int c = lane & 7;
#pragma unroll
    for (int j = 0; j < 4; ++j) { const int n = (lane >> 3) + 8 * j; const LAS float* s = scr + (8 * c) * 33 + n;
        v4u o; o.x = pk2(s[0 * 33], s[1 * 33]); o.y = pk2(s[2 * 33], s[3 * 33]); o.z = pk2(s[4 * 33], s[5 * 33]); o.w = pk2(s[6 * 33], s[7 * 33]);
        *(GAS v4u*)(WT + (size_t)(drow0 + n) * ldt + k0 + 8 * c) = o; }
    LDS_WAIT(); asm volatile("" ::: "memory");
}
__device__ __forceinline__ void p0_transpose_item_f8(const float* W, int ldw, unsigned char* WT, int ldt, int k0, int n0, int drow0, float scale, LAS float* scr, int lane) {
#pragma unroll 8
    for (int i = 0; i < 32; ++i) { const int kk = 2 * i + (lane >> 5); scr[kk * 33 + (lane & 31)] = W[(size_t)(k0 + kk) * ldw + n0 + (lane & 31)] * scale; }
    LDS_WAIT(); asm volatile("" ::: "memory");
    const int c = lane & 7;
#pragma unroll
    for (int j = 0; j < 4; ++j) { const int n = (lane >> 3) + 8 * j; const LAS float* s = scr + (8 * c) * 33 + n;
        v2u o; o.x = pg8::pk4f8(s[0 * 33], s[1 * 33], s[2 * 33], s[3 * 33]); o.y = pg8::pk4f8(s[4 * 33], s[5 * 33], s[6 * 33], s[7 * 33]);
        *(GAS v2u*)(WT + (size_t)(drow0 + n) * ldt + k0 + 8 * c) = o; }
    LDS_WAIT(); asm volatile("" ::: "memory");
}
__device__ __forceinline__ void p0_fold_item(Frame& F, int item, LAS float* T, int lane) {
    const int g = item >> 6, nb = (item >> 1) & 31, ii = item & 1, n0 = 32 * nb;
#pragma unroll 8
    for (int j2 = 0; j2 < 64; ++j2) { const int o = 2 * j2 + (lane >> 5), n = lane & 31; T[o * 32 + n] = F.pool_scale[g * 128 + o] * F.w_out[(size_t)(512 + g * 128 + o) * DM + n0 + n]; }
    LDS_WAIT(); asm volatile("" ::: "memory");
    const int i = 64 * ii + lane; const float* pw = F.pool_w + (size_t)(g * 128 + i) * 128;
    f32x4 acc[8];
#pragma unroll
    for (int q = 0; q < 8; ++q) acc[q] = (f32x4){0.f, 0.f, 0.f, 0.f};
    for (int o4 = 0; o4 < 32; ++o4) { const f32x4 a = *(const f32x4*)(pw + 4 * o4);
#pragma unroll
        for (int oo = 0; oo < 4; ++oo)
#pragma unroll
            for (int q = 0; q < 8; ++q) acc[q] += a[oo] * *(const LAS f32x4*)(T + (4 * o4 + oo) * 32 + 4 * q); }
#pragma unroll
    for (int q = 0; q < 8; ++q)
#pragma unroll
        for (int j = 0; j < 4; ++j) F.WOUT_T[(size_t)(n0 + 4 * q + j) * DM + 512 + g * 128 + i] = (bf16)(pk2(acc[q][j], 0.f) & 0xffffu);
    LDS_WAIT(); asm volatile("" ::: "memory");
}
__device__ __forceinline__ void p0_weights(Frame& F) {
    LAS float* scr = (LAS float*)(F.lds + RING_OFF + F.wave * 16384);
    const int gw = (int)blockIdx.x * NWAVES + F.wave, NGW = F.G * NWAVES;
    constexpr int I_IN = 16 * 96, I_OUT = 8 * 32, I_G = 16 * 88, I_D = 44 * 32, I_F = 256;
    constexpr int NITEMS = I_IN + I_OUT + 2 * I_G + I_D + I_F;
    for (int it = gw; it < NITEMS; it += NGW) {
        int r = it;
        if (r < I_F) { p0_fold_item(F, r, scr, F.lane); continue; } r -= I_F;
        if (r < I_IN) { const int kb = r / 96, nb = r % 96; p0_transpose_item(F.w_in, DIN_, F.WIN_T, DM, 64 * kb, 32 * nb, 32 * nb, scr, F.lane); continue; } r -= I_IN;
        if (r < I_OUT) { const int kb = r / 32, nb = r % 32; p0_transpose_item(F.w_out, DM, F.WOUT_T, DM, 64 * kb, 32 * nb, 32 * nb, scr, F.lane); continue; } r -= I_OUT;
        if (r < I_G) { const int kb = r / 88, nb = r % 88, n0 = 32 * nb; p0_transpose_item_f8(F.w_g, DFF_, (unsigned char*)F.WGU_T, DM, 64 * kb, n0, 256 * (n0 >> 7) + (n0 & 127), pg8::F8_W_SCALE, scr, F.lane); continue; } r -= I_G;
        if (r < I_G) { const int kb = r / 88, nb = r % 88, n0 = 32 * nb; p0_transpose_item_f8(F.w_u, DFF_, (unsigned char*)F.WGU_T, DM, 64 * kb, n0, 256 * (n0 >> 7) + 128 + (n0 & 127), pg8::F8_W_SCALE, scr, F.lane); continue; } r -= I_G;
        { const int kb = r / 32, nb = r % 32; p0_transpose_item_f8(F.w_d, DM, (unsigned char*)F.WDN_T, DFF_, 64 * kb, 32 * nb, 32 * nb, pg8::F8_WD_SCALE, scr, F.lane); }
    }
}
__device__ __forceinline__ void p1_h1(Frame& F) {
    const int gw = (int)blockIdx.x * NWAVES + F.wave, NGW = F.G * NWAVES;
    for (int u = gw; u < MTOK / 4; u += NGW) {
        const int row0 = 4 * u, mi = mod_index(row0); const float* sh = F.MOD + mi * MODW_ + 4 * F.lane; const float* sc = sh + 1024;
        f32x4 s[4], t[4];
#pragma unroll
        for (int j = 0; j < 4; ++j) { s[j] = *(const f32x4*)(sc + 256 * j) + 1.0f; t[j] = *(const f32x4*)(sh + 256 * j); }
#pragma unroll
        for (int rr = 0; rr < 4; ++rr) { const int row = row0 + rr; const float* xr = (row < NP ? F.xp + (size_t)row * DM : F.xs + (size_t)(row - NP) * DM) + 4 * F.lane; bf16* o = F.A + (size_t)row * DM + 4 * F.lane;
#pragma unroll
            for (int j = 0; j < 4; ++j) { const f32x4 v = *(const f32x4*)(xr + 256 * j) * s[j] + t[j]; v2u w; w.x = pk2(v[0], v[1]); w.y = pk2(v[2], v[3]); *(v2u*)(o + 256 * j) = w; } }
    }
}
constexpr int SC_QD = 0, SC_KI = 8704, SC_KET = 17408, SC_VT = 27648, SC_DEC = 37888, SC_BUF = 38400;
#define MFMA32(a, b, c) __builtin_amdgcn_mfma_f32_32x32x16_bf16((a), (b), (c), 0, 0, 0)
__device__ __forceinline__ int crow16(int reg, int h) { return (reg & 3) + 8 * (reg >> 2) + 4 * h; }
template <int S2> __device__ __forceinline__ bf16x8 pack8(const f32x16& x) {
    v4u p; p.x = pk2(x[8 * S2 + 0], x[8 * S2 + 1]); p.y = pk2(x[8 * S2 + 2], x[8 * S2 + 3]); p.z = pk2(x[8 * S2 + 4], x[8 * S2 + 5]); p.w = pk2(x[8 * S2 + 6], x[8 * S2 + 7]);
    return __builtin_bit_cast(bf16x8, p);
}
__device__ __forceinline__ bf16x8 lds8(const LAS unsigned char* p) { return *(const LAS bf16x8*)p; }

struct ScanRegs { unsigned q[8], k[8], v[8]; };
template <int DIR> __device__ __forceinline__ void scan_load(ScanRegs& R, const bf16* qp, const bf16* kp, const bf16* vp, int rowbase, int T, int n, int g) {
#pragma unroll
    for (int i = 0; i < 8; ++i) { const int c = 32 * n + 8 * g + i, t = DIR ? (T - 1 - c) : c; const size_t off = (size_t)(rowbase + t) * DIN_;
        R.q[i] = *(const unsigned*)(qp + off); R.k[i] = *(const unsigned*)(kp + off); R.v[i] = *(const unsigned*)(vp + off); }
}
__device__ __forceinline__ void scan_produce(const ScanRegs& R, LAS unsigned char* buf, int g, int cp, int lane) {
    float k0[8], k1[8], P0[8], P1[8]; float run0 = 1.f, run1 = 1.f;
#pragma unroll
    for (int i = 0; i < 8; ++i) { k0[i] = bflo(R.k[i]); k1[i] = bfhi(R.k[i]); run0 *= (1.f - k0[i]); run1 *= (1.f - k1[i]); P0[i] = run0; P1[i] = run1; }
    const float a1 = __shfl(run0, (lane - 16) & 63), a2 = __shfl(run0, (lane - 32) & 63), a3 = __shfl(run0, (lane - 48) & 63);
    const float b1 = __shfl(run1, (lane - 16) & 63), b2 = __shfl(run1, (lane - 32) & 63), b3 = __shfl(run1, (lane - 48) & 63);
    const float pre0 = (g >= 1 ? a1 : 1.f) * (g >= 2 ? a2 : 1.f) * (g >= 3 ? a3 : 1.f), pre1 = (g >= 1 ? b1 : 1.f) * (g >= 2 ? b2 : 1.f) * (g >= 3 ? b3 : 1.f);
    const float tot0 = __shfl(pre0 * run0, 48 + (lane & 15)), tot1 = __shfl(pre1 * run1, 48 + (lane & 15));
    const int d0 = 2 * cp, dl = d0 & 15, pos = (d0 & ~15) | (dl & 3) | (((dl >> 2) & 1) << 3) | (((dl >> 3) & 1) << 2);
    unsigned ke0[8], ke1[8];
#pragma unroll
    for (int i = 0; i < 8; ++i) {
        const float E0 = pre0 * P0[i], E1 = pre1 * P1[i], I0 = __builtin_amdgcn_rcpf(E0), I1 = __builtin_amdgcn_rcpf(E1);
        const float ki0 = k0[i] * I0, ki1 = k1[i] * I1;
        const int c = 8 * g + i;
        *(LAS unsigned*)(buf + SC_QD + c * 272 + pos * 2) = pk2(bflo(R.q[i]) * E0, bfhi(R.q[i]) * E1);
        *(LAS unsigned*)(buf + SC_KI + c * 272 + pos * 2) = pk2(ki0, ki1);
        const unsigned kk = pk2(ki0 * tot0, ki1 * tot1); ke0[i] = kk & 0xffffu; ke1[i] = kk >> 16;
    }
#pragma unroll
    for (int hh = 0; hh < 2; ++hh) {
        const int sp = (16 * (g >> 1) + 8 * hh + 4 * (g & 1)) * 2;
        v2u a, b, c, d;
        a.x = ke0[4 * hh] | (ke0[4 * hh + 1] << 16); a.y = ke0[4 * hh + 2] | (ke0[4 * hh + 3] << 16);
        b.x = ke1[4 * hh] | (ke1[4 * hh + 1] << 16); b.y = ke1[4 * hh + 2] | (ke1[4 * hh + 3] << 16);
        c.x = (R.v[4 * hh] & 0xffffu) | (R.v[4 * hh + 1] << 16); c.y = (R.v[4 * hh + 2] & 0xffffu) | (R.v[4 * hh + 3] << 16);
        d.x = (R.v[4 * hh] >> 16) | (R.v[4 * hh + 1] & 0xffff0000u); d.y = (R.v[4 * hh + 2] >> 16) | (R.v[4 * hh + 3] & 0xffff0000u);
        *(LAS v2u*)(buf + SC_KET + d0 * 80 + sp) = a; *(LAS v2u*)(buf + SC_KET + (d0 + 1) * 80 + sp) = b;
        *(LAS v2u*)(buf + SC_VT + d0 * 80 + sp) = c; *(LAS v2u*)(buf + SC_VT + (d0 + 1) * 80 + sp) = d;
    }
    if (g == 0) *(LAS f32x2*)(buf + SC_DEC + d0 * 4) = (f32x2){tot0, tot1};
}
template <int DIR> __device__ __forceinline__ void scan_item(Frame& F, int rowbase, int T, int h, const float* S0, float* Sout, bf16* O) {
    LAS unsigned char* lds = F.lds;
    int lane_ = F.lane; asm volatile("" : "+v"(lane_));
    const int N = T >> 5, lane = lane_, wid = F.wave;
    if (wid >= 4) {
        const int pw = wid - 4, g = lane >> 4, cp = 16 * pw + (lane & 15);
        const bf16* qp = F.B + h * 128 + 2 * cp; const bf16* kp = qp + (DIR ? 1024 : 512); const bf16* vp = qp + 1536;
        ScanRegs cur, nxt;
        scan_load<DIR>(cur, qp, kp, vp, rowbase, T, 0, g);
        scan_load<DIR>(nxt, qp, kp, vp, rowbase, T, 1, g);
        scan_produce(cur, lds, g, cp, lane);
        __syncthreads();
        for (int n = 0; n < N; ++n) {
            if (n + 1 < N) {
                cur = nxt;
                if (n + 2 < N) scan_load<DIR>(nxt, qp, kp, vp, rowbase, T, n + 2, g);
                scan_produce(cur, lds + ((n + 1) & 1) * SC_BUF, g, cp, lane);
#ifdef DUP_PROD
                asm volatile("" : "+v"(cur.q[0]), "+v"(cur.k[0]), "+v"(cur.v[0])); scan_produce(cur, lds + ((n + 1) & 1) * SC_BUF, g, cp, lane);
#endif
            }
            __syncthreads();
        }
    } else {
        const int w = wid, r = lane & 31, hh = lane >> 5;
        f32x16 S[4];
#pragma unroll
        for (int t = 0; t < 4; ++t)
#pragma unroll
            for (int i = 0; i < 16; ++i) S[t][i] = S0 ? S0[(size_t)(32 * t + crow16(i, hh)) * 128 + 32 * w + r] : 0.f;
        __syncthreads();
        for (int n = 0; n < N; ++n) {
            const LAS unsigned char* buf = lds + (n & 1) * SC_BUF;
            const LAS unsigned char* qd = buf + SC_QD + r * 272 + 16 * hh; const LAS unsigned char* ki = buf + SC_KI + r * 272 + 16 * hh;
            const LAS unsigned char* vt = buf + SC_VT + (32 * w + r) * 80 + 16 * hh;
            f32x16 X, o;
#pragma unroll
            for (int i = 0; i < 16; ++i) { X[i] = 0.f; o[i] = 0.f; }
#pragma unroll
            for (int kk = 0; kk < 8; ++kk) X = MFMA32(lds8(ki + 32 * kk), lds8(qd + 32 * kk), X);
#pragma unroll
            for (int t = 0; t < 4; ++t) { o = MFMA32(lds8(qd + 64 * t), pack8<0>(S[t]), o); o = MFMA32(lds8(qd + 64 * t + 32), pack8<1>(S[t]), o); }
#pragma unroll
            for (int i = 0; i < 16; ++i) X[i] = (crow16(i, hh) <= r) ? X[i] : 0.f;
            const bf16x8 v0 = lds8(vt), v1 = lds8(vt + 32);
            o = MFMA32(pack8<0>(X), v0, o); o = MFMA32(pack8<1>(X), v1, o);
#pragma unroll
            for (int t = 0; t < 4; ++t) {
#pragma unroll
                for (int g4 = 0; g4 < 4; ++g4) { const f32x4 dv = *(const LAS f32x4*)(buf + SC_DEC + (32 * t + 8 * g4 + 4 * hh) * 4);
#pragma unroll
                    for (int b = 0; b < 4; ++b) S[t][4 * g4 + b] *= dv[b]; }
                const LAS unsigned char* ke = buf + SC_KET + (32 * t + r) * 80 + 16 * hh;
                S[t] = MFMA32(lds8(ke), v0, S[t]); S[t] = MFMA32(lds8(ke + 32), v1, S[t]);
            }
            { const int cb = 32 * n + 4 * hh; size_t oo = (size_t)(rowbase + (DIR ? (T - 1 - cb) : cb)) * DREC + h * 128 + 32 * w + r;
              asm volatile("" : "+v"(oo));
              bf16* op = O + oo;
#pragma unroll
              for (int i = 0; i < 16; ++i) { const int cr = (i & 3) + 8 * (i >> 2); op[DIR ? -(cr * DREC) : (cr * DREC)] = (bf16)(pk2(o[i], 0.f) & 0xffffu); } }
            __syncthreads();
        }
        if (Sout) {
#pragma unroll
            for (int t = 0; t < 4; ++t)
#pragma unroll
                for (int i = 0; i < 16; ++i) Sout[(size_t)(32 * t + crow16(i, hh)) * 128 + 32 * w + r] = S[t][i];
        }
    }
}
__device__ __forceinline__ void unpack8(const v4u raw, float (&f)[8]) { f[0] = bflo(raw.x); f[1] = bfhi(raw.x); f[2] = bflo(raw.y); f[3] = bfhi(raw.y); f[4] = bflo(raw.z); f[5] = bfhi(raw.z); f[6] = bflo(raw.w); f[7] = bfhi(raw.w); }
template <int HW> __device__ __forceinline__ void pool_lat_item_t(Frame& F, int b, int gi, int r) {
    LAS float* V = (LAS float*)F.lds;
    const size_t tok0 = (size_t)NP + (size_t)b * TS;
    const int r0 = r - HW < 0 ? 0 : r - HW, r1 = r + HW > 64 ? 64 : r + HW;
    v4u ctr[2];
#pragma unroll
    for (int q = 0; q < 2; ++q) { const int idx = F.tid + 512 * q, c = idx >> 4, ch0 = (idx & 15) * 8;
        const bf16* up = F.B + (tok0 + c) * DIN_ + 2560 + gi * 128 + ch0;
        v4u raw[2 * HW];
#pragma unroll
        for (int j = 0; j < 2 * HW; ++j) { const int rp = r - HW + j; raw[j] = (v4u){0u, 0u, 0u, 0u}; if (rp >= 0 && rp < 64) raw[j] = *(const v4u*)(up + (size_t)rp * 64 * DIN_); }
        float a[8];
#pragma unroll
        for (int j = 0; j < 8; ++j) a[j] = 0.f;
#pragma unroll
        for (int j = 0; j < 2 * HW; ++j) { float f[8]; unpack8(raw[j], f);
#pragma unroll
            for (int e = 0; e < 8; ++e) a[e] += f[e]; }
        ctr[q] = raw[HW];
        *(LAS f32x4*)(V + c * 128 + ch0) = (f32x4){a[0], a[1], a[2], a[3]}; *(LAS f32x4*)(V + c * 128 + ch0 + 4) = (f32x4){a[4], a[5], a[6], a[7]}; }
    __syncthreads();
#pragma unroll
    for (int q = 0; q < 2; ++q) { const int idx = F.tid + 512 * q, c = idx >> 4, ch0 = (idx & 15) * 8;
        const int c0 = c - HW < 0 ? 0 : c - HW, c1 = c + HW > 64 ? 64 : c + HW;
        f32x4 s0 = (f32x4){0.f, 0.f, 0.f, 0.f}, s1 = s0;
#pragma unroll
        for (int j = 0; j < 2 * HW; ++j) { const int cq = c - HW + j; if (cq >= 0 && cq < 64) { s0 += *(const LAS f32x4*)(V + cq * 128 + ch0); s1 += *(const LAS f32x4*)(V + cq * 128 + ch0 + 4); } }
        const float inv = 1.0f / (float)((r1 - r0) * (c1 - c0)); float f[8]; unpack8(ctr[q], f);
        v4u o; o.x = pk2(s0[0] * inv - f[0], s0[1] * inv - f[1]); o.y = pk2(s0[2] * inv - f[2], s0[3] * inv - f[3]); o.z = pk2(s1[0] * inv - f[4], s1[1] * inv - f[5]); o.w = pk2(s1[2] * inv - f[6], s1[3] * inv - f[7]);
        *(v4u*)(F.A + (tok0 + r * 64 + c) * DM + 512 + gi * 128 + ch0) = o; }
    __syncthreads();
}
__device__ __forceinline__ void pool_lat_item(Frame& F, int b, int gi, int r) {
    if (gi == 0) pool_lat_item_t<1>(F, b, gi, r); else if (gi == 1) pool_lat_item_t<2>(F, b, gi, r); else if (gi == 2) pool_lat_item_t<4>(F, b, gi, r); else pool_lat_item_t<8>(F, b, gi, r);
}
template <int HW> __device__ __forceinline__ void pool_ctx_item_t(Frame& F, int b, int gi, int seg) {
    const size_t tok0 = (size_t)b * TP;
#pragma unroll
    for (int q = 0; q < 2; ++q) { const int idx = F.tid + 512 * q, t = seg * 64 + (idx >> 4), ch0 = (idx & 15) * 8;
        const int t0 = t - HW < 0 ? 0 : t - HW, t1 = t + HW > TP ? TP : t + HW;
        const bf16* up = F.B + tok0 * DIN_ + 2560 + gi * 128 + ch0;
        v4u raw[2 * HW];
#pragma unroll
        for (int j = 0; j < 2 * HW; ++j) { const int tq = t - HW + j; raw[j] = (v4u){0u, 0u, 0u, 0u}; if (tq >= 0 && tq < TP) raw[j] = *(const v4u*)(up + (size_t)tq * DIN_); }
        float a[8];
#pragma unroll
        for (int j = 0; j < 8; ++j) a[j] = 0.f;
#pragma unroll
        for (int j = 0; j < 2 * HW; ++j) { float f[8]; unpack8(raw[j], f);
#pragma unroll
            for (int e = 0; e < 8; ++e) a[e] += f[e]; }
        const float inv = 1.0f / (float)(t1 - t0); float f[8]; unpack8(raw[HW], f);
        v4u o; o.x = pk2(a[0] * inv - f[0], a[1] * inv - f[1]); o.y = pk2(a[2] * inv - f[2], a[3] * inv - f[3]); o.z = pk2(a[4] * inv - f[4], a[5] * inv - f[5]); o.w = pk2(a[6] * inv - f[6], a[7] * inv - f[7]);
        *(v4u*)(F.A + (tok0 + t) * DM + 512 + gi * 128 + ch0) = o; }
}
__device__ __forceinline__ void pool_ctx_item(Frame& F, int b, int gi, int seg) {
    if (gi == 0) pool_ctx_item_t<1>(F, b, gi, seg); else if (gi == 1) pool_ctx_item_t<2>(F, b, gi, seg); else if (gi == 2) pool_ctx_item_t<4>(F, b, gi, seg); else pool_ctx_item_t<8>(F, b, gi, seg);
}
__device__ __forceinline__ void scan_dispatch(Frame& F, int it) {
    if (it < 64) { const int b = it >> 3, h = (it >> 1) & 3, dir = it & 1;
        if (dir) scan_item<1>(F, NP + b * TS, TS, h, F.st_b + (size_t)(b * 4 + h) * 16384, nullptr, F.OB); else scan_item<0>(F, NP + b * TS, TS, h, F.st_f + (size_t)(b * 4 + h) * 16384, nullptr, F.OF);
    } else { const int j = it - 64, b = j >> 3, h = (j >> 1) & 3, dir = j & 1;
        float* so = F.out + (size_t)MTOK * DM + (size_t)dir * (32 * 4 * 16384) + (size_t)(b * 4 + h) * 16384;
        if (dir) scan_item<1>(F, b * TP, TP, h, nullptr, so, F.OB); else scan_item<0>(F, b * TP, TP, h, nullptr, so, F.OF); }
}
__device__ __forceinline__ void pool_dispatch(Frame& F, int it) {
    if (it < 2048) pool_lat_item(F, it >> 8, (it >> 6) & 3, it & 63);
    else { const int j = it - 2048; pool_ctx_item(F, j >> 4, (j >> 2) & 3, j & 3); }
}
__device__ __forceinline__ void p3_scan_pool(Frame& F) {
    const int bx = blockIdx.x, G = F.G;
    if (G >= 128) {
        if (bx < 64) { scan_dispatch(F, bx);
#ifdef DUP_LAT
            scan_dispatch(F, bx);
#endif
        }
        else { const int np = G - 64;
            for (int it = 64 + (bx - 64); it < 320; it += np) scan_dispatch(F, it);
            for (int it = bx - 64; it < 2560; it += np) pool_dispatch(F, it); }
    } else {
        for (int it = bx; it < 320; it += G) scan_dispatch(F, it);
        for (int it = bx; it < 2560; it += G) pool_dispatch(F, it);
    }
}
__device__ __forceinline__ void p4_yrec(Frame& F) {
    const int gw = (int)blockIdx.x * NWAVES + F.wave, NGW = F.G * NWAVES, c0 = 8 * F.lane;
    const f32x4 n0 = *(const f32x4*)(F.ng + (c0 & 127)), n1 = *(const f32x4*)(F.ng + (c0 & 127) + 4);
    for (int row = gw; row < MTOK; row += NGW) {
        const v4u a = *(const v4u*)(F.OF + (size_t)row * DREC + c0), b = *(const v4u*)(F.OB + (size_t)row * DREC + c0), gg = *(const v4u*)(F.B + (size_t)row * DIN_ + 2048 + c0);
        float fa[8], fb[8], fg[8], o[8]; unpack8(a, fa); unpack8(b, fb); unpack8(gg, fg);
        float ss = 0.f;
#pragma unroll
        for (int j = 0; j < 8; ++j) { o[j] = fa[j] + fb[j]; ss += o[j] * o[j]; }
        ss += __shfl_xor(ss, 1); ss += __shfl_xor(ss, 2); ss += __shfl_xor(ss, 4); ss += __shfl_xor(ss, 8);
        const float rs = 1.0f / sqrtf(ss * (1.0f / 128.0f) + RMS_EPS);
        v4u w; w.x = pk2(o[0] * rs * n0[0] * fg[0], o[1] * rs * n0[1] * fg[1]); w.y = pk2(o[2] * rs * n0[2] * fg[2], o[3] * rs * n0[3] * fg[3]);
        w.z = pk2(o[4] * rs * n1[0] * fg[4], o[5] * rs * n1[1] * fg[5]); w.w = pk2(o[6] * rs * n1[2] * fg[6], o[7] * rs * n1[3] * fg[7]);
        *(v4u*)(F.A + (size_t)row * DM + c0) = w;
    }
}
__device__ __forceinline__ void p6_ln1(Frame& F) {
    const int gw = (int)blockIdx.x * NWAVES + F.wave, NGW = F.G * NWAVES;
    for (int row = gw; row < MTOK; row += NGW) {
        bf16* rp = F.R1 + (size_t)row * DM + 8 * F.lane; float v[16];
        { const v4u a = *(const v4u*)rp, b = *(const v4u*)(rp + 512); float fa[8], fb[8]; unpack8(a, fa); unpack8(b, fb);
#pragma unroll
          for (int j = 0; j < 8; ++j) { v[j] = fa[j]; v[8 + j] = fb[j]; } }
        float s = 0.f;
#pragma unroll
        for (int j = 0; j < 16; ++j) s += v[j];
        const float mean = wave_sum(s) * (1.0f / DM); float s2 = 0.f;
#pragma unroll
        for (int j = 0; j < 16; ++j) { v[j] -= mean; s2 += v[j] * v[j]; }
        const float rstd = 1.0f / sqrtf(wave_sum(s2) * (1.0f / DM) + LN_EPS);
        const float* md = F.MOD + mod_index(row) * MODW_ + 8 * F.lane;
#pragma unroll
        for (int hf = 0; hf < 2; ++hf) { const int cc = 8 * F.lane + 512 * hf; float x1[8], h2[8];
#pragma unroll
            for (int q = 0; q < 2; ++q) { const f32x4 g = *(const f32x4*)(F.ln1g + cc + 4 * q), bb = *(const f32x4*)(F.ln1b + cc + 4 * q);
                const f32x4 sh = *(const f32x4*)(md + 3072 + 512 * hf + 4 * q), sc = *(const f32x4*)(md + 4096 + 512 * hf + 4 * q);
#pragma unroll
                for (int j = 0; j < 4; ++j) { const float x = v[8 * hf + 4 * q + j] * rstd * g[j] + bb[j]; x1[4 * q + j] = x; h2[4 * q + j] = x * (1.0f + sc[j]) + sh[j]; } }
            v4u w1; w1.x = pk2(x1[0], x1[1]); w1.y = pk2(x1[2], x1[3]); w1.z = pk2(x1[4], x1[5]); w1.w = pk2(x1[6], x1[7]);
#pragma unroll
            for (int j = 0; j < 8; ++j) h2[j] = pg8::clamp8(h2[j] * pg8::F8_ACT_SCALE);
            v2u w8; w8.x = pg8::pk4f8(h2[0], h2[1], h2[2], h2[3]); w8.y = pg8::pk4f8(h2[4], h2[5], h2[6], h2[7]);
            *(v4u*)(rp + 512 * hf) = w1; *(v2u*)((unsigned char*)F.A + (size_t)row * DM + cc) = w8; }
    }
}
__device__ __forceinline__ void p9_ln2(Frame& F) {
    const int gw = (int)blockIdx.x * NWAVES + F.wave, NGW = F.G * NWAVES;
    f32x4 g[4], bb[4];
#pragma unroll
    for (int j = 0; j < 4; ++j) { g[j] = *(const f32x4*)(F.ln2g + 4 * F.lane + 256 * j); bb[j] = *(const f32x4*)(F.ln2b + 4 * F.lane + 256 * j); }
    for (int row = gw; row < MTOK; row += NGW) {
        float* xr = F.out + (size_t)row * DM + 4 * F.lane; f32x4 v[4]; float s = 0.f;
#pragma unroll
        for (int j = 0; j < 4; ++j) { v[j] = *(const f32x4*)(xr + 256 * j); s += (v[j][0] + v[j][1]) + (v[j][2] + v[j][3]); }
        const float mean = wave_sum(s) * (1.0f / DM); float s2 = 0.f;
#pragma unroll
        for (int j = 0; j < 4; ++j) { v[j] = v[j] - mean; s2 += (v[j][0] * v[j][0] + v[j][1] * v[j][1]) + (v[j][2] * v[j][2] + v[j][3] * v[j][3]); }
        const float rstd = 1.0f / sqrtf(wave_sum(s2) * (1.0f / DM) + LN_EPS);
#pragma unroll
        for (int j = 0; j < 4; ++j) *(f32x4*)(xr + 256 * j) = v[j] * rstd * g[j] + bb[j];
    }
}

#define RELANE() do { int t_ = threadIdx.x; asm volatile("" : "+v"(t_)); F.tid = t_; F.lane = t_ & 63; } while (0)
struct Args { const float* in[22]; float* out; unsigned char* ws; };
__global__ void __launch_bounds__(NWAVES * 64, 2) hymba_fwd(Args args) {
    extern __shared__ __attribute__((aligned(16))) unsigned char lds[];
    Frame F;
    F.lds = (LAS unsigned char*)lds;
    F.MISC = (volatile LAS unsigned*)(F.lds + MISC_OFF);
    F.tid = threadIdx.x; F.lane = F.tid & 63; F.wave = __builtin_amdgcn_readfirstlane(F.tid >> 6); F.G = gridDim.x;
    unsigned char* ws = args.ws;
    F.ctl = (gu32*)(ws + WS_CTL);
    F.xp = args.in[0]; F.xs = args.in[1]; F.st_f = args.in[2]; F.st_b = args.in[3]; F.c = args.in[4]; F.c_ctx = args.in[5]; F.w_mod = args.in[6]; F.b_mod = args.in[7];
    F.w_in = args.in[8]; F.lbf = args.in[9]; F.lbb = args.in[10]; F.ng = args.in[11]; F.pool_w = args.in[12]; F.pool_scale = args.in[13]; F.w_out = args.in[14];
    F.ln1g = args.in[15]; F.ln1b = args.in[16]; F.w_g = args.in[17]; F.w_u = args.in[18]; F.w_d = args.in[19]; F.ln2g = args.in[20]; F.ln2b = args.in[21];
    F.out = args.out; F.MOD = (float*)(ws + WS_MOD);
    F.WIN_T = (bf16*)(ws + WS_WIN); F.WOUT_T = (bf16*)(ws + WS_WOUT); F.WGU_T = (bf16*)(ws + WS_WGU); F.WDN_T = (bf16*)(ws + WS_WDN);
    F.A = (bf16*)(ws + WS_A); F.B = (bf16*)(ws + WS_B); F.OF = (bf16*)(ws + WS_C); F.OB = F.OF + (size_t)MTOK * DREC; F.R1 = (bf16*)(ws + WS_C);
    for (int u = F.tid; u < (LDS_BYTES - LDSCTL_OFF) / 4; u += NWAVES * 64) ((LAS unsigned*)(F.lds + LDSCTL_OFF))[u] = 0u;
    __syncthreads();
    XcdBarrier bar = xcd_barrier_post((unsigned*)(F.ctl + CW_BAR), F.MISC + 8);

    RELANE();
    p0_mod(F);
    RELANE();
    p0_weights(F);
    xcd_barrier(bar);
    RELANE();
    p1_h1(F);
    xcd_barrier(bar);
    { pg8::Gemm g{F.A, F.WIN_T, MTOK, DIN_, DM}; pg8::StaticOrder S; S.init(MTOK, DIN_, F.G, (int)blockIdx.x);
      pg8::EpiInProj E{F.B, F.lbf, F.lbb};
      pg8::gemm_phase<pg8::EpiInProj, pg8::StaticOrder, true, true>(F.lds + RING_OFF, g, S, E); }
    xcd_barrier(bar);
    RELANE();
    p3_scan_pool(F);
    xcd_barrier(bar);
#ifdef DUP_P3
    p3_scan_pool(F);
    xcd_barrier(bar);
#endif
    RELANE();
    p4_yrec(F);
    xcd_barrier(bar);
    { pg8::Gemm g{F.A, F.WOUT_T, MTOK, DM, DM}; pg8::StaticOrder S; S.init(MTOK, DM, F.G, (int)blockIdx.x);
      pg8::EpiOutProj E{F.R1, F.xp, F.xs, F.MOD};
      pg8::gemm_phase<pg8::EpiOutProj, pg8::StaticOrder, true, true>(F.lds + RING_OFF, g, S, E); }
    xcd_barrier(bar);
    RELANE();
    p6_ln1(F);
    xcd_barrier(bar);
    { pg8::Gemm g{F.A, F.WGU_T, MTOK, 2 * DFF_, DM / 2}; pg8::StaticOrder S; S.init(MTOK, 2 * DFF_, F.G, (int)blockIdx.x);
      pg8::EpiGateUp E{(unsigned char*)F.B};
      pg8::gemm_phase<pg8::EpiGateUp, pg8::StaticOrder, true, true, true>(F.lds + RING_OFF, g, S, E); }
    xcd_barrier(bar);
    { pg8::Gemm g{F.B, F.WDN_T, MTOK, DM, DFF_ / 2}; pg8::StaticOrder S; S.init(MTOK, DM, F.G, (int)blockIdx.x);
      pg8::EpiDown E{F.out, F.R1, F.MOD};
      pg8::gemm_phase<pg8::EpiDown, pg8::StaticOrder, true, true, true>(F.lds + RING_OFF, g, S, E); }
    xcd_barrier(bar);
    RELANE();
    p9_ln2(F);
}

extern "C" void kernel_launch(void* const* d_in, const int* in_sizes, int n_in, void* d_out, int out_size, void* d_ws, size_t ws_size, hipStream_t stream) {
    static int grid = 0;
    if (grid == 0) {
        if (n_in != 22 || out_size != MTOK * DM + 2 * 32 * 4 * 16384 || ws_size < WS_END) { fprintf(stderr, "kernel_launch: unexpected shapes (n_in %d, out %d, ws %zu); nothing launched\n", n_in, out_size, ws_size); grid = -1; return; }
        int dev = 0, cus = 0, per_cu = 0;
        if (hipGetDevice(&dev) != hipSuccess || hipDeviceGetAttribute(&cus, hipDeviceAttributeMultiprocessorCount, dev) != hipSuccess) { grid = -1; return; }
        if (hipFuncSetAttribute((const void*)hymba_fwd, hipFuncAttributeMaxDynamicSharedMemorySize, LDS_BYTES) != hipSuccess) { fprintf(stderr, "kernel_launch: hipFuncSetAttribute failed\n"); grid = -1; return; }
        if (hipOccupancyMaxActiveBlocksPerMultiprocessor(&per_cu, (const void*)hymba_fwd, NWAVES * 64, LDS_BYTES) != hipSuccess || per_cu < 1) { fprintf(stderr, "kernel_launch: occupancy query says %d blocks per CU; nothing launched\n", per_cu); (void)hipGetLastError(); grid = -1; return; }
        grid = cus;
    }
    if (grid < 0) return;
    if (hipMemsetAsync((char*)d_ws + WS_CTL, 0, CTL_ZERO_BYTES, stream) != hipSuccess) return;
    Args a{};
    for (int i = 0; i < 22; ++i) a.in[i] = (const float*)d_in[i];
    a.out = (float*)d_out; a.ws = (unsigned char*)d_ws;
    hipLaunchKernelGGL(hymba_fwd, dim3(grid), dim3(NWAVES * 64), LDS_BYTES, stream, a);
}
```
